# Optimizing an MI355X kernel written in HIP

```python
import math
import jax, jax.numpy as jnp
from jax import lax
import numpy as np

D_MODEL = 1024
BATCH = 8
SEQ = 2048
DEPTH = 2
DEC_BATCH = 128
DEC_SEQ = 1
PAST_LEN = 16384
PAGE_SIZE = 128

N_MIXERS = 2
N_CONV_LAYERS = (DEPTH + 1) // 2
N_REC_LAYERS = DEPTH // 2
CONV_WIDTH = 3
REC_HEAD_DIM = 128
REC_HEADS = D_MODEL // REC_HEAD_DIM
CHUNK = 64
N_MEM = 256
X_HEADS = 4
X_HEAD_DIM = D_MODEL // X_HEADS
D_FF = 2816
EPS = 1e-6

kernel_name = "macaron_conv_hgrn2_memxattn_step"


def rmsnorm(x, g):
    xf = x.astype(jnp.float32)
    y = xf * lax.rsqrt(jnp.mean(xf * xf, axis=-1, keepdims=True) + EPS)
    return (y * g.astype(jnp.float32)).astype(x.dtype)


def swiglu(x, w_gate, w_up, w_down):
    return (jax.nn.silu(x @ w_gate) * (x @ w_up)) @ w_down


def short_conv_mixer(x, buf, w_in, w_conv, w_out):
    T = x.shape[1]
    b_gate, c_gate, u = jnp.split(x @ w_in, 3, axis=-1)
    v = c_gate * u
    vv = jnp.concatenate([buf.astype(v.dtype), v], axis=1)
    conv = sum(w_conv[j] * vv[:, j:j + T] for j in range(CONV_WIDTH))
    y = (b_gate * conv) @ w_out
    return y, vv[:, vv.shape[1] - (CONV_WIDTH - 1):]


def hgrn2_lower_bounds(lb_raw):
    p = jax.nn.softmax(lb_raw.astype(jnp.float32), axis=0)
    return jnp.cumsum(p, axis=0) - p[0]


def gla_chunked(q, k, logf, v, S0):
    B, T, H, K = q.shape
    V = v.shape[-1]
    C = min(CHUNK, T)
    n = -(-T // C)
    pad = n * C - T

    def to_chunks(a):
        a = jnp.pad(a, ((0, 0), (0, pad), (0, 0), (0, 0)))
        return a.reshape(B, n, C, H, a.shape[-1]).transpose(1, 0, 2, 3, 4)

    causal = jnp.tril(jnp.ones((C, C), dtype=bool))[None, :, :, None, None]

    def step(S, blk):
        qc, kc, lc, vc = blk
        b = jnp.cumsum(lc, axis=1)
        o_inter = jnp.einsum('bchk,bhkv->bchv', qc * jnp.exp(b), S)
        diff = b[:, :, None] - b[:, None, :]
        decay = jnp.where(causal, jnp.exp(jnp.where(causal, diff, 0.0)), 0.0)
        att = jnp.einsum('bthk,btshk,bshk->bhts', qc, decay, kc)
        o_intra = jnp.einsum('bhts,bshv->bthv', att, vc)
        b_last = b[:, -1:]
        S_new = jnp.exp(b_last[:, 0])[..., None] * S + jnp.einsum('bshk,bshv->bhkv', kc * jnp.exp(b_last - b), vc)
        return S_new, o_inter + o_intra

    S, o = lax.scan(step, S0, (to_chunks(q), to_chunks(k), to_chunks(logf), to_chunks(v)))
    o = o.transpose(1, 0, 2, 3, 4).reshape(B, n * C, H, V)[:, :T]
    return o, S


def hgrn2_mixer(x, S0, lb, w_in, g_onorm, w_out):
    B, T, D = x.shape
    f32 = jnp.float32
    q, fz, i, g = jnp.split(x @ w_in, 4, axis=-1)
    lb32 = lb.astype(f32)
    logf = jnp.logaddexp(jnp.log(lb32), jnp.log1p(-lb32) + jax.nn.log_sigmoid(fz.astype(f32)))
    k = -jnp.expm1(logf)
    hs = lambda a: a.reshape(B, T, REC_HEADS, REC_HEAD_DIM)
    o, S = gla_chunked(hs(jax.nn.silu(q.astype(f32))), hs(k), hs(logf), hs(i.astype(f32)), S0.astype(f32))
    o = rmsnorm(o, g_onorm) * jax.nn.silu(hs(g.astype(f32)))
    y = o.reshape(B, T, D).astype(x.dtype) @ w_out
    return y, S.astype(S0.dtype)


def mem_kv(mem, g_mem, w_kv):
    B, N, _ = mem.shape
    k, v = jnp.split(rmsnorm(mem, g_mem) @ w_kv, 2, axis=-1)
    return k.reshape(B, N, X_HEADS, X_HEAD_DIM), v.reshape(B, N, X_HEADS, X_HEAD_DIM)


def cross_attn(x, mk, mv, w_q, w_o):
    B, T, D = x.shape
    q = (x @ w_q).reshape(B, T, X_HEADS, X_HEAD_DIM)
    s = jnp.einsum('bthd,bnhd->bhtn', q, mk.astype(q.dtype)).astype(jnp.float32) / math.sqrt(X_HEAD_DIM)
    p = jax.nn.softmax(s, axis=-1).astype(x.dtype)
    o = jnp.einsum('bhtn,bnhd->bthd', p, mv.astype(x.dtype)).reshape(B, T, D)
    return o @ w_o


def setup_inputs(seed: int = 0) -> dict:
    key = jax.random.key(seed)
    ks = iter(jax.random.split(key, 40))
    nrm = lambda shape, scale: jax.random.normal(next(ks), shape, jnp.float32) * scale
    gain = lambda shape: 1.0 + 0.05 * jax.random.normal(next(ks), shape, jnp.float32)
    D = D_MODEL
    return {
        "x_prompt": nrm((BATCH, SEQ, D), 1.0),
        "x_sample": nrm((DEC_BATCH, DEC_SEQ, D), 1.0),
        "mem_prompt": nrm((BATCH, N_MEM, D), 1.0),
        "state_conv": nrm((N_CONV_LAYERS, DEC_BATCH, CONV_WIDTH - 1, D), 1.0),
        "state_rec": nrm((N_REC_LAYERS, DEC_BATCH, REC_HEADS, REC_HEAD_DIM, REC_HEAD_DIM), 0.3),
        "cache_mem_k": nrm((DEPTH, DEC_BATCH, N_MEM, X_HEADS, X_HEAD_DIM), 1.0),
        "cache_mem_v": nrm((DEPTH, DEC_BATCH, N_MEM, X_HEADS, X_HEAD_DIM), 1.0),
        "norm_ffn1": gain((DEPTH, D)),
        "w_ffn1_gate": nrm((DEPTH, D, D_FF), D ** -0.5),
        "w_ffn1_up": nrm((DEPTH, D, D_FF), D ** -0.5),
        "w_ffn1_down": nrm((DEPTH, D_FF, D), D_FF ** -0.5),
        "norm_mix": gain((DEPTH, D)),
        "w_conv_in": nrm((N_CONV_LAYERS, D, 3 * D), D ** -0.5),
        "w_conv": nrm((N_CONV_LAYERS, CONV_WIDTH, D), CONV_WIDTH ** -0.5),
        "w_conv_out": nrm((N_CONV_LAYERS, D, D), D ** -0.5),
        "lb_raw": nrm((DEPTH, D), 0.1),
        "w_rec_in": nrm((N_REC_LAYERS, D, 4 * D), D ** -0.5),
        "g_rec_onorm": gain((N_REC_LAYERS, REC_HEAD_DIM)),
        "w_rec_out": nrm((N_REC_LAYERS, D, D), D ** -0.5),
        "norm_xattn": gain((DEPTH, D)),
        "norm_mem": gain((DEPTH, D)),
        "w_xq": nrm((DEPTH, D, D), D ** -0.5),
        "w_xkv": nrm((DEPTH, D, 2 * D), D ** -0.5),
        "w_xo": nrm((DEPTH, D, D), D ** -0.5),
        "norm_ffn2": gain((DEPTH, D)),
        "w_ffn2_gate": nrm((DEPTH, D, D_FF), D ** -0.5),
        "w_ffn2_up": nrm((DEPTH, D, D_FF), D ** -0.5),
        "w_ffn2_down": nrm((DEPTH, D_FF, D), D_FF ** -0.5),
        "norm_final": gain((D,)),
    }


def reference(x_prompt, x_sample, mem_prompt, state_conv, state_rec, cache_mem_k, cache_mem_v,
              norm_ffn1, w_ffn1_gate, w_ffn1_up, w_ffn1_down, norm_mix,
              w_conv_in, w_conv, w_conv_out, lb_raw, w_rec_in, g_rec_onorm, w_rec_out,
              norm_xattn, norm_mem, w_xq, w_xkv, w_xo,
              norm_ffn2, w_ffn2_gate, w_ffn2_up, w_ffn2_down, norm_final):
    lower_bounds = hgrn2_lower_bounds(lb_raw)

    def trunk(x, conv_state, rec_state, mem_k, mem_v):
        new_conv, new_rec = [], []
        for i in range(DEPTH):
            h = rmsnorm(x, norm_ffn1[i])
            x = x + 0.5 * swiglu(h, w_ffn1_gate[i], w_ffn1_up[i], w_ffn1_down[i])
            h = rmsnorm(x, norm_mix[i])
            j = i // N_MIXERS
            if i % N_MIXERS == 0:
                y, buf = short_conv_mixer(h, conv_state[j], w_conv_in[j], w_conv[j], w_conv_out[j])
                new_conv.append(buf)
            else:
                y, S = hgrn2_mixer(h, rec_state[j], lower_bounds[i], w_rec_in[j], g_rec_onorm[j], w_rec_out[j])
                new_rec.append(S)
            x = x + y
            h = rmsnorm(x, norm_xattn[i])
            x = x + cross_attn(h, mem_k[i], mem_v[i], w_xq[i], w_xo[i])
            h = rmsnorm(x, norm_ffn2[i])
            x = x + 0.5 * swiglu(h, w_ffn2_gate[i], w_ffn2_up[i], w_ffn2_down[i])
        return rmsnorm(x, norm_final), jnp.stack(new_conv), jnp.stack(new_rec)

    B = x_prompt.shape[0]
    kv_p = [mem_kv(mem_prompt, norm_mem[i], w_xkv[i]) for i in range(DEPTH)]
    mem_k_p = jnp.stack([kv[0] for kv in kv_p])
    mem_v_p = jnp.stack([kv[1] for kv in kv_p])
    conv0 = jnp.zeros((N_CONV_LAYERS, B, CONV_WIDTH - 1, D_MODEL), x_prompt.dtype)
    rec0 = jnp.zeros((N_REC_LAYERS, B, REC_HEADS, REC_HEAD_DIM, REC_HEAD_DIM), x_prompt.dtype)
    y_prompt, conv_p, rec_p = trunk(x_prompt, conv0, rec0, mem_k_p, mem_v_p)

    y_sample, conv_s, rec_s = trunk(x_sample, state_conv, state_rec, cache_mem_k, cache_mem_v)

    return (y_prompt, y_sample, mem_k_p, mem_v_p, conv_p, rec_p, conv_s, rec_s)
```

```cpp
#include <hip/hip_runtime.h>
#include <hip/hip_cooperative_groups.h>
#include <cstdio>
#include <cstdint>
namespace cg = cooperative_groups;

#ifndef DBG_MASK
#define DBG_MASK 0xFFFFF
#endif
#define DM(b) ((DBG_MASK >> (b)) & 1)
#ifndef REP_GS
#define REP_GS -1
#endif
#ifndef REP_N
#define REP_N 0
#endif
#ifndef REP_PARTS
#define REP_PARTS 7
#endif
#define LAS __attribute__((address_space(3)))
typedef unsigned short bf16;
typedef short bf16x8 __attribute__((ext_vector_type(8)));
typedef float f32x4 __attribute__((ext_vector_type(4)));
typedef float f32x2 __attribute__((ext_vector_type(2)));
typedef unsigned u32x4 __attribute__((ext_vector_type(4)));
typedef unsigned u32x2 __attribute__((ext_vector_type(2)));

constexpr int D = 1024, NB = 8, T = 2048, MP = NB * T, NS = 128, MT = MP + NS, MPAD = 16640, FF = 2816;
constexpr int NMEM = 256, MEMR = NB * NMEM;
constexpr float EPS = 1e-6f;
constexpr float QSCALE = 0.0625f * 1.4426950408889634f;
constexpr int NTHR = 512, NWAVES = 8;

constexpr size_t al256(size_t x) { return (x + 255) & ~(size_t)255; }
constexpr size_t WS_CTL = 0, CTL_BYTES = 65536;
constexpr size_t WS_SSQ = CTL_BYTES;
constexpr size_t WS_MSSQ = WS_SSQ + al256((size_t)9 * MPAD * 4);
constexpr size_t WS_WGU = WS_MSSQ + al256(MEMR * 4);
constexpr size_t SZ_WGU = (size_t)2 * FF * D * 2;
constexpr size_t WS_WD = WS_WGU + 4 * SZ_WGU;
constexpr size_t SZ_WD = (size_t)D * FF * 2;
constexpr size_t WS_WQ = WS_WD + 4 * SZ_WD;
constexpr size_t SZ_DD = (size_t)D * D * 2;
constexpr size_t WS_WKV = WS_WQ + 2 * SZ_DD;
constexpr size_t WS_WO = WS_WKV + 4 * SZ_DD;
constexpr size_t WS_WMO = WS_WO + 2 * SZ_DD;
constexpr size_t WS_WCI = WS_WMO + 2 * SZ_DD;
constexpr size_t WS_WRI = WS_WCI + 3 * SZ_DD;
constexpr size_t WS_X = WS_WRI + 4 * SZ_DD;
constexpr size_t SZ_ACT2 = (size_t)MPAD * D * 2, SZ_ACT4 = (size_t)MPAD * D * 4;
constexpr size_t WS_XB = WS_X + SZ_ACT4;
constexpr size_t WS_H = WS_XB + SZ_ACT2;
constexpr size_t WS_MEMB = WS_H + (size_t)MPAD * FF * 2;
constexpr size_t WS_MEMK = WS_MEMB + (size_t)MEMR * D * 2;
constexpr size_t WS_VT = WS_MEMK + 2 * (size_t)MEMR * D * 2;
constexpr size_t WS_Q = WS_VT + 2 * (size_t)MEMR * D * 2;
constexpr size_t WS_P = WS_Q + SZ_ACT2;
constexpr size_t WS_O = WS_P + SZ_ACT2;
constexpr size_t WS_M1 = WS_O + SZ_ACT2;
constexpr size_t WS_M2 = WS_M1 + SZ_ACT2;
constexpr size_t WS_RG = WS_M2 + SZ_ACT2;
constexpr size_t WS_LOGF = WS_RG + SZ_ACT2;
constexpr size_t WS_G = WS_LOGF + SZ_ACT4;
constexpr size_t WS_QBG = WS_G + SZ_ACT2;
constexpr size_t WS_OINTRA = WS_QBG + (size_t)MP * D * 2;
constexpr size_t WS_UT = WS_OINTRA + (size_t)MP * D * 4;
constexpr size_t WS_SPT = WS_UT + (size_t)2048 * 16384 * 4;
constexpr size_t WS_DEC = WS_SPT + (size_t)2048 * 16384 * 2;
constexpr size_t WS_WQN = WS_DEC + (size_t)2048 * 128 * 4;
constexpr size_t WS_WQK = WS_WQN + 2 * SZ_DD;
constexpr size_t WS_VWT = WS_WQK + 2 * 8 * SZ_DD;
constexpr size_t WS_END = WS_VWT + 2 * 8 * SZ_DD;
static_assert(WS_END <= (size_t)1023 * 1024 * 1024, "workspace map too large");

constexpr size_t OUT_YP = 0, OUT_YS = (size_t)MP * D, OUT_MK = OUT_YS + (size_t)NS * D, OUT_MV = OUT_MK + (size_t)2 * MEMR * D,
                 OUT_CP = OUT_MV + (size_t)2 * MEMR * D, OUT_RP = OUT_CP + (size_t)NB * 2 * D, OUT_CS = OUT_RP + (size_t)NB * 8 * 16384,
                 OUT_RS = OUT_CS + (size_t)NS * 2 * D;

constexpr int LDS_STAGE = 131072, LDS_SCR = 131072, LDS_MISC = LDS_SCR + 12288, LDS_BYTES = 147456;

__device__ __forceinline__ unsigned f2bf(float f) { unsigned u = __builtin_bit_cast(unsigned, f); return (u + 0x7fffu + ((u >> 16) & 1u)) >> 16; }
typedef __bf16 bf16x2_t __attribute__((ext_vector_type(2)));
typedef _Float16 f16x4 __attribute__((ext_vector_type(4)));
__device__ __forceinline__ unsigned pk2(float lo, float hi) { const f32x2 v = {lo, hi}; const bf16x2_t b = __builtin_convertvector(v, bf16x2_t); return __builtin_bit_cast(unsigned, b); }
__device__ __forceinline__ float bf2f(unsigned b) { return __builtin_bit_cast(float, b << 16); }
__device__ __forceinline__ float bflo(unsigned w) { return __builtin_bit_cast(float, w << 16); }
__device__ __forceinline__ float bfhi(unsigned w) { return __builtin_bit_cast(float, w & 0xffff0000u); }
__device__ __forceinline__ float wave_sum(float v) {
#pragma unroll
    for (int o = 1; o < 64; o <<= 1) v += __shfl_xor(v, o);
    return v;
}
__device__ __forceinline__ float wave_max(float v) {
#pragma unroll
    for (int o = 1; o < 64; o <<= 1) v = fmaxf(v, __shfl_xor(v, o));
    return v;
}
__device__ __forceinline__ int otid() { int t; asm volatile("v_mov_b32 %0, %1" : "=v"(t) : "v"((int)threadIdx.x)); return t; }
__device__ __forceinline__ float silu_f(float g) { return g * __builtin_amdgcn_rcpf(1.f + __expf(-g)); }
#define LDS_WAIT() asm volatile("s_waitcnt lgkmcnt(0)" ::: "memory")

#define XB_TMO      128
#define XB_XCNT(j)  (256  + 64 * (j))
#define XB_XSUB(j)  (1280 + 64 * (j))
#define XB_XGEN(j)  (2304 + 64 * (j))
#define XB_TOP      3328
#define XB_TOPGEN   3392
#define XCD_BAR_WORDS 3456
#define XB_SPIN_CAP (1u << 22)
__device__ __forceinline__ unsigned xb_ld(unsigned* p)              { return __hip_atomic_load(p, __ATOMIC_RELAXED, __HIP_MEMORY_SCOPE_AGENT); }
__device__ __forceinline__ unsigned xb_add(unsigned* p, unsigned v) { return __hip_atomic_fetch_add(p, v, __ATOMIC_RELAXED, __HIP_MEMORY_SCOPE_AGENT); }
__device__ __forceinline__ unsigned xb_xcc_id() { return (unsigned)__builtin_amdgcn_s_getreg((3 << 11) | 20) & 0xFu; }
#define XB_SPIN(cond, bar) do { unsigned _sp = 0; while (cond) { __builtin_amdgcn_s_sleep(1); \
    if ((++_sp & 255u) == 0u) { if (xb_ld(&(bar)[XB_TMO])) break; if (_sp > XB_SPIN_CAP) { atomicAdd(&(bar)[XB_TMO], 1u); break; } } } } while (0)
struct XcdBarrier { unsigned* bar; unsigned x; volatile LAS unsigned* st; };
__device__ __forceinline__ XcdBarrier xcd_barrier_post(unsigned* bar, volatile LAS unsigned* st) {
    XcdBarrier b; b.bar = bar; b.x = xb_xcc_id(); b.st = st;
    if (threadIdx.x == 0) (void)xb_add(&bar[XB_XCNT(b.x)], 1u);
    return b;
}
__device__ __forceinline__ void xcd_barrier_complete(unsigned* bar, unsigned x, unsigned& nloc, unsigned& nx) {
    const unsigned G = gridDim.x * gridDim.y * gridDim.z;
    unsigned sum, cnt, mine, sp = 0u;
    for (;;) {
        sum = 0u; cnt = 0u; mine = 0u;
#pragma unroll
        for (unsigned j = 0; j < 16; ++j) { const unsigned c = xb_ld(&bar[XB_XCNT(j)]); sum += c; cnt += (c > 0u) ? 1u : 0u; mine = (j == x) ? c : mine; }
        if (sum == G) break;
        __builtin_amdgcn_s_sleep(1);
        if ((++sp & 255u) == 0u) { if (xb_ld(&bar[XB_TMO])) break; if (sp > XB_SPIN_CAP) { atomicAdd(&bar[XB_TMO], 1u); break; } }
    }
    nloc = mine > 0u ? mine : 1u; nx = cnt > 0u ? cnt : 1u;
}
__device__ __forceinline__ void xcd_barrier(const XcdBarrier& b) {
    asm volatile("s_waitcnt vmcnt(0)" ::: "memory");
    __syncthreads();
    if (threadIdx.x == 0) {
        unsigned* bar = b.bar;
        __builtin_amdgcn_s_waitcnt(0);
        unsigned nloc = b.st[0], nx = b.st[1];
        if (nloc == 0u) { xcd_barrier_complete(bar, b.x, nloc, nx); b.st[0] = nloc; b.st[1] = nx; }
        const unsigned old = xb_add(&bar[XB_XSUB(b.x)], 1u);
        const unsigned gen = old / nloc;
        if (old + 1u == (gen + 1u) * nloc) {
            __builtin_amdgcn_fence(__ATOMIC_RELEASE, "agent");
            asm volatile("s_waitcnt vmcnt(0)" ::: "memory");
            const unsigned og = xb_add(&bar[XB_TOP], 1u);
            const unsigned tg = og / nx;
            if (og + 1u == (tg + 1u) * nx) xb_add(&bar[XB_TOPGEN], 1u);
            else XB_SPIN(xb_ld(&bar[XB_TOPGEN]) == tg, bar);
            __builtin_amdgcn_fence(__ATOMIC_ACQUIRE, "agent");
            xb_add(&bar[XB_XGEN(b.x)], 1u);
            asm volatile("s_waitcnt vmcnt(0)" ::: "memory");
        } else {
            XB_SPIN(xb_ld(&bar[XB_XGEN(b.x)]) == gen, bar);
            __builtin_amdgcn_fence(__ATOMIC_ACQUIRE, "agent");
            asm volatile("s_waitcnt vmcnt(0)" ::: "memory");
        }
    }
    __syncthreads();
}

namespace pg8 {
constexpr int BM = 256, BK = 64, HALF = 128, HTB = HALF * BK * 2, STAGE_BYTES = 8 * HTB, NXCD = 8, WGM = 8;
__device__ __forceinline__ int lds_byte(int r, int c) { const int st = (r >> 4) * 2 + (c >> 5), rr = r & 15, cc = c & 31, ob = rr * 64 + cc * 2; return st * 1024 + (ob ^ (((ob >> 9) & 1) << 5)); }
__device__ __forceinline__ void stage_rc(int b, int& R, int& C) { const int st = b / 1024, sb = b % 1024, swz = sb ^ (((sb >> 9) & 1) << 5); R = (st >> 1) * 16 + swz / 64; C = (st & 1) * 32 + (swz % 64) / 2; }

struct Unit { const char* A; const char* B; int row0, col0, nt, kind; };

typedef f32x4 Acc[2][2][4][2];

template <class Epi, class Sched>
__device__ __forceinline__ void gemm_phase(LAS unsigned char* lds, int K, int lda, int ldb, const Sched& S, const Epi& E) {
    const int tid = otid(), wid = __builtin_amdgcn_readfirstlane(tid >> 6), lane = tid & 63, wr = wid >> 2, wc = wid & 3, fr = lane & 15, fq = lane >> 4;
    unsigned voffA[2], voffB[2];
#pragma unroll
    for (int i = 0; i < 2; ++i) { int R, C; stage_rc(tid * 16 + i * 8192, R, C); const int rho = R & 31, Rb = (R & ~31) + 8 * ((rho & 15) >> 2) + 4 * (rho >> 4) + (rho & 3);
        voffA[i] = (unsigned)(R * lda + C) * 2u; voffB[i] = (unsigned)(Rb * ldb + C) * 2u; }
    const size_t kstep = (size_t)(BK * 2);
    const size_t hstepA = (size_t)HALF * lda * 2, hstepB = (size_t)HALF * ldb * 2;
    const unsigned ldsw = (unsigned)wid * 1024u;
    const int aoff = lds_byte(wr * 64 + fr, fq * 8), boff = lds_byte(wc * 32 + fr, fq * 8);
#define PG8_SA(b, h) (((b) * 2 + (h)) * HTB)
#define PG8_SB(b, h) ((4 + (b) * 2 + (h)) * HTB)
#define PG8_STAGE(bufoff, gbase, voff) do { _Pragma("unroll") for (int _i = 0; _i < 2; ++_i) \
        __builtin_amdgcn_global_load_lds((const unsigned*)((const char*)(gbase) + (voff)[_i]), (LAS unsigned*)(lds + (bufoff) + ldsw + _i * 8192), 16, 0, 0); } while (0)
#define PG8_LDA(dst, b, h) do { _Pragma("unroll") for (int m = 0; m < 4; ++m) _Pragma("unroll") for (int k = 0; k < 2; ++k) dst[m][k] = *(const LAS bf16x8*)(lds + PG8_SA(b, h) + aoff + m * 2048 + k * 1024); } while (0)
#define PG8_LDB(dst, b, h) do { _Pragma("unroll") for (int n = 0; n < 2; ++n) _Pragma("unroll") for (int k = 0; k < 2; ++k) dst[n][k] = *(const LAS bf16x8*)(lds + PG8_SB(b, h) + boff + n * 2048 + k * 1024); } while (0)
#define PG8_MMA(ai, bj, At, Bt) do { __builtin_amdgcn_s_setprio(1); _Pragma("unroll") for (int m = 0; m < 4; ++m) _Pragma("unroll") for (int n = 0; n < 2; ++n) _Pragma("unroll") for (int k = 0; k < 2; ++k) \
        acc[ai][bj][m][n] = __builtin_amdgcn_mfma_f32_16x16x32_bf16(Bt[n][k], At[m][k], acc[ai][bj][m][n], 0, 0, 0); __builtin_amdgcn_s_setprio(0); } while (0)
#define PG8_WAIT_V(n) asm volatile("s_waitcnt vmcnt(" #n ")" ::: "memory")
#define PG8_WAIT_L(n) asm volatile("s_waitcnt lgkmcnt(" #n ")" ::: "memory")
#define PG8_BAR __builtin_amdgcn_s_barrier()
#define PG8_SCHED __builtin_amdgcn_sched_barrier(0)
    Unit cur, nxt; int ui = 0;
    if (!S.next(0, cur)) return;
    Acc acc;
#pragma unroll
    for (int a = 0; a < 2; ++a)
#pragma unroll
        for (int b = 0; b < 2; ++b)
#pragma unroll
            for (int m = 0; m < 4; ++m)
#pragma unroll
                for (int n = 0; n < 2; ++n) acc[a][b][m][n] = (f32x4){0.f, 0.f, 0.f, 0.f};
    bf16x8 At[4][2], B0[2][2], B1[2][2];
    const char* cA = cur.A; const char* cB = cur.B;
    PG8_STAGE(PG8_SB(0, 0), cB, voffB); PG8_STAGE(PG8_SB(0, 1), cB + hstepB, voffB); PG8_STAGE(PG8_SA(0, 0), cA, voffA); PG8_STAGE(PG8_SA(0, 1), cA + hstepA, voffA);
    if (wr == 1) PG8_BAR;
    PG8_WAIT_V(2); PG8_BAR;
    PG8_STAGE(PG8_SB(1, 0), cB + kstep, voffB); PG8_STAGE(PG8_SA(1, 0), cA + kstep, voffA); PG8_STAGE(PG8_SB(1, 1), cB + hstepB + kstep, voffB);
    PG8_WAIT_V(6); PG8_BAR;
    for (;;) {
        const bool has_next = S.next(ui + 1, nxt);
        const char* nA = has_next ? nxt.A : cA; const char* nB = has_next ? nxt.B : cB;
#pragma unroll 1
        for (int t = 0; t < cur.nt; t += 2) {
            const bool last = (t == cur.nt - 2);
            const char* a1 = cA + (size_t)(t + 1) * kstep;
            const char* a2 = last ? nA : cA + (size_t)(t + 2) * kstep; const char* b2 = last ? nB : cB + (size_t)(t + 2) * kstep;
            const char* a3 = a2 + kstep; const char* b3 = b2 + kstep;
            PG8_LDB(B0, 0, 0); PG8_LDB(B1, 0, 1); PG8_SCHED; PG8_LDA(At, 0, 0); PG8_STAGE(PG8_SA(1, 1), a1 + hstepA, voffA);
            PG8_WAIT_V(8); PG8_WAIT_L(0); PG8_BAR; PG8_MMA(0, 0, At, B0); PG8_MMA(0, 1, At, B1); PG8_BAR; PG8_SCHED;
            PG8_LDA(At, 0, 1); PG8_STAGE(PG8_SB(0, 0), b2, voffB); PG8_STAGE(PG8_SB(0, 1), b2 + hstepB, voffB); PG8_STAGE(PG8_SA(0, 0), a2, voffA);
            PG8_WAIT_V(8); PG8_WAIT_L(0); PG8_BAR; PG8_MMA(1, 0, At, B0); PG8_MMA(1, 1, At, B1); PG8_BAR; PG8_SCHED;
            PG8_LDB(B0, 1, 0); PG8_LDB(B1, 1, 1); PG8_SCHED; PG8_LDA(At, 1, 0); PG8_STAGE(PG8_SA(0, 1), a2 + hstepA, voffA);
            PG8_WAIT_V(8); PG8_WAIT_L(0); PG8_BAR; PG8_MMA(0, 0, At, B0); PG8_MMA(0, 1, At, B1); PG8_BAR; PG8_SCHED;
            PG8_LDA(At, 1, 1); PG8_STAGE(PG8_SB(1, 0), b3, voffB); PG8_STAGE(PG8_SB(1, 1), b3 + hstepB, voffB); PG8_STAGE(PG8_SA(1, 0), a3, voffA);
            PG8_WAIT_V(8); PG8_WAIT_L(0); PG8_BAR; PG8_MMA(1, 0, At, B0); PG8_MMA(1, 1, At, B1); PG8_BAR; PG8_SCHED;
        }
        if (wr == 0) PG8_BAR;
        E(acc, cur, wr, wc, fr, fq);
        if (!has_next) break;
#pragma unroll
        for (int a = 0; a < 2; ++a)
#pragma unroll
            for (int b = 0; b < 2; ++b)
#pragma unroll
                for (int m = 0; m < 4; ++m)
#pragma unroll
                    for (int n = 0; n < 2; ++n) acc[a][b][m][n] = (f32x4){0.f, 0.f, 0.f, 0.f};
        cur = nxt; cA = nA; cB = nB; ++ui;
        if (wr == 1) PG8_BAR;
    }
    PG8_WAIT_V(0);
    PG8_BAR;
#undef PG8_SA
#undef PG8_SB
#undef PG8_STAGE
#undef PG8_LDA
#undef PG8_LDB
#undef PG8_MMA
}

struct Sched2D {
    const char* A; const char* B; int lda, ldb, nM, nN, nwg, G, c; size_t bstride;
    __device__ __forceinline__ void init(const bf16* A_, int lda_, const bf16* B_, int ldb_, int M, int N, int G_, int c_) {
        A = (const char*)A_; B = (const char*)B_; bstride = 0; lda = lda_; ldb = ldb_; nM = M / BM; nN = N / BM; nwg = nM * nN; G = G_; c = c_; }
    __device__ __forceinline__ bool next(int i, Unit& u) const {
        const long L = (long)i * G + c; if (L >= nwg) return false;
        int wgid = (int)L; { const int q = nwg / NXCD, r = nwg % NXCD, xcd = wgid % NXCD, off = wgid / NXCD; wgid = (xcd < r ? xcd * (q + 1) : r * (q + 1) + (xcd - r) * q) + off; }
        const int nig = WGM * nN, gid = wgid / nig, fm = gid * WGM, gsz = (nM - fm) < WGM ? (nM - fm) : WGM;
        const int pm = fm + ((wgid % nig) % gsz), pn = (wgid % nig) / gsz;
        u.A = A + (size_t)pm * BM * lda * 2; u.B = B + (size_t)(pm >> 3) * bstride + (size_t)pn * BM * ldb * 2; u.row0 = pm * BM; u.col0 = pn * BM; return true;
    }
};
struct SchedAttn {
    const char* A; const char* B; int mode, G, c;
    __device__ __forceinline__ bool next(int i, Unit& u) const {
        const int L = i * G + c; if (L >= 256) return false;
        const int wgid = (L % NXCD) * 32 + L / NXCD;
        const int bh = wgid >> 3, qt = wgid & 7, b = bh >> 2, h = bh & 3;
        u.row0 = b * T + qt * 256; u.col0 = h * 256;
        u.A = A + ((size_t)u.row0 * D + h * 256) * 2;
        u.B = mode == 0 ? B + ((size_t)(b * NMEM) * D + h * 256) * 2 : B + ((size_t)(h * 256) * MEMR + b * NMEM) * 2;
        return true;
    }
};

constexpr float SSQ_FX = 1024.f;
__device__ __forceinline__ float ssq_rstd(const float* ssq, unsigned row) { return rsqrtf((float)*(const unsigned*)((const char*)ssq + row * 4u) * (1.f / (SSQ_FX * D)) + EPS); }
__device__ __forceinline__ void ssq_add(float* ssq, unsigned row, float ss) { atomicAdd((unsigned*)ssq + row, (unsigned)(ss * SSQ_FX + 0.5f)); }
#define EPI_ARGS const Acc& acc, const Unit& u, int wr, int wc, int fr, int fq
#define FOR_AM _Pragma("unroll") for (int ai = 0; ai < 2; ++ai) _Pragma("unroll") for (int m = 0; m < 4; ++m)
#define FOR_BN _Pragma("unroll") for (int bj = 0; bj < 2; ++bj) _Pragma("unroll") for (int n = 0; n < 2; ++n)
#define LOAD_RSTD(rr, ssqp, rbase) float rr[2][4]; FOR_AM rr[ai][m] = ssq_rstd(ssqp, (rbase) + ai * 128 + m * 16)
#define EPI_FENCE() do { asm volatile("" ::: "memory"); __builtin_amdgcn_sched_barrier(0); } while (0)
template <class Tp> __device__ __forceinline__ Tp& at(void* base, unsigned byteoff) { return *(Tp*)((char*)base + byteoff); }
template <class Tp> __device__ __forceinline__ const Tp& atc(const void* base, unsigned byteoff) { return *(const Tp*)((const char*)base + byteoff); }
__device__ __forceinline__ u32x2 pk4(const f32x4 v) { u32x2 w; w.x = pk2(v[0], v[1]); w.y = pk2(v[2], v[3]); return w; }
__device__ __forceinline__ u32x4 pk8(const f32x4 v0, const f32x4 v1) { u32x4 w; w.x = pk2(v0[0], v0[1]); w.y = pk2(v0[2], v0[3]); w.z = pk2(v1[0], v1[1]); w.w = pk2(v1[2], v1[3]); return w; }
#define FOR_BJ _Pragma("unroll") for (int bj = 0; bj < 2; ++bj)

struct EpiGU { bf16* H; const float* ssq;
    __device__ __forceinline__ void operator()(EPI_ARGS) const {
        const unsigned hcol = (u.col0 >> 1) + wc * 32 + 8 * fq; const unsigned rb = u.row0 + wr * 64 + fr;
        LOAD_RSTD(rr, ssq, rb);
        FOR_AM { const unsigned row = rb + ai * 128 + m * 16; const float r = rr[ai][m];
            f32x4 hv[2];
#pragma unroll
            for (int n = 0; n < 2; ++n) { const f32x4 g = acc[ai][0][m][n] * r, up = acc[ai][1][m][n] * r;
                const f32x4 t = __builtin_elementwise_max(g, (f32x4){-30.f, -30.f, -30.f, -30.f}) * -1.4426950408889634f;
                const f32x4 d = (f32x4){__builtin_amdgcn_exp2f(t[0]), __builtin_amdgcn_exp2f(t[1]), __builtin_amdgcn_exp2f(t[2]), __builtin_amdgcn_exp2f(t[3])} + 1.f;
                const f32x4 ds = __builtin_shufflevector(d, d, 1, 0, 3, 2), p = d * ds;
                const float r01 = __builtin_amdgcn_rcpf(p[0]), r23 = __builtin_amdgcn_rcpf(p[2]);
                hv[n] = (g * up) * (ds * (f32x4){r01, r01, r23, r23}); }
            at<u32x4>(H, (row * FF + hcol) * 2u) = pk8(hv[0], hv[1]);
            EPI_FENCE(); }
    }
};
struct EpiRes { const float* Xin; bf16* XB; float* ssq_out; float alpha;
    __device__ __forceinline__ void operator()(EPI_ARGS) const {
        const unsigned rb = u.row0 + wr * 64 + fr, cb = u.col0 + wc * 32 + 8 * fq;
#pragma unroll
        for (int ai = 0; ai < 2; ++ai) {
            u32x4 xpre[4][2];
            if (!Xin) {
#pragma unroll
                for (int m = 0; m < 4; ++m) { FOR_BJ { xpre[m][bj] = atc<u32x4>(XB, ((rb + ai * 128 + m * 16) * D + cb + bj * 128) * 2u); } } }
#pragma unroll
            for (int m = 0; m < 4; ++m) { const unsigned row = rb + ai * 128 + m * 16; float ss = 0.f;
                FOR_BJ { const unsigned off = row * D + cb + bj * 128; f32x4 x0, x1;
                    if (Xin) { x0 = atc<f32x4>(Xin, off * 4u); x1 = atc<f32x4>(Xin, off * 4u + 16u); }
                    else { const u32x4 xw = xpre[m][bj]; x0 = (f32x4){bflo(xw.x), bfhi(xw.x), bflo(xw.y), bfhi(xw.y)}; x1 = (f32x4){bflo(xw.z), bfhi(xw.z), bflo(xw.w), bfhi(xw.w)}; }
                    const f32x4 v0 = x0 + acc[ai][bj][m][0] * alpha, v1 = x1 + acc[ai][bj][m][1] * alpha;
                    ss += ((v0[0] * v0[0] + v0[1] * v0[1]) + (v0[2] * v0[2] + v0[3] * v0[3])) + ((v1[0] * v1[0] + v1[1] * v1[1]) + (v1[2] * v1[2] + v1[3] * v1[3]));
                    at<u32x4>(XB, off * 2u) = pk8(v0, v1); }
                ss += __shfl_xor(ss, 16); ss += __shfl_xor(ss, 32);
                if (fq == 0) ssq_add(ssq_out, row, ss);
                EPI_FENCE(); }
        }
    }
};
struct EpiConvIn { bf16* CB; bf16* CV; const float* ssq; float* out_cp; float* out_cs;
    __device__ __forceinline__ void operator()(EPI_ARGS) const {
        const int pn = u.col0 >> 8; const unsigned rb = u.row0 + wr * 64 + fr;
        LOAD_RSTD(rr, ssq, rb);
        if (pn < 4) {
            const unsigned cb = u.col0 + wc * 32 + 8 * fq;
            FOR_AM { const unsigned row = rb + ai * 128 + m * 16; const float r = rr[ai][m];
                FOR_BJ { at<u32x4>(CB, (row * D + cb + bj * 128) * 2u) = pk8(acc[ai][bj][m][0] * r, acc[ai][bj][m][1] * r); }
                EPI_FENCE(); }
        } else {
            const unsigned cb = (pn - 4) * 128 + wc * 32 + 8 * fq;
            FOR_AM { const unsigned row = rb + ai * 128 + m * 16; const float r = rr[ai][m];
#pragma unroll
                for (int n = 0; n < 2; ++n) { const unsigned ch = cb + n * 4; const f32x4 v = (acc[ai][0][m][n] * r) * (acc[ai][1][m][n] * r);
                    at<u32x2>(CV, (row * D + ch) * 2u) = pk4(v);
                    if (row < (unsigned)MP) { const unsigned t = row & (T - 1); if (t >= (unsigned)(T - 2)) at<f32x4>(out_cp, (((row >> 11) * 2 + (t - (T - 2))) * D + ch) * 4u) = v; }
                    else if (row < (unsigned)MT) at<f32x4>(out_cs, (((row - MP) * 2 + 1) * D + ch) * 4u) = v; }
                EPI_FENCE(); }
        }
    }
};
struct EpiRecIn { bf16* RQ; _Float16* LOGF; bf16* RI; bf16* RG; const float* ssq; const float* lb_raw;
    __device__ __forceinline__ void operator()(EPI_ARGS) const {
        const int pn = u.col0 >> 8, part = pn >> 2; const unsigned rb = u.row0 + wr * 64 + fr, cb = (pn & 3) * 256 + wc * 32 + 8 * fq;
        LOAD_RSTD(rr, ssq, rb);
        if (part == 1) {
            f32x4 lbv[2][2];
            FOR_BN { const unsigned ch = cb + bj * 128 + n * 4; const f32x4 l0 = atc<f32x4>(lb_raw, ch * 4u), l1 = atc<f32x4>(lb_raw, (D + ch) * 4u);
#pragma unroll
                for (int e = 0; e < 4; ++e) lbv[bj][n][e] = __builtin_amdgcn_rcpf(1.f + __expf(l0[e] - l1[e])); }
            FOR_AM { const unsigned row = rb + ai * 128 + m * 16; const float r = rr[ai][m];
                FOR_BN { const f32x4 v = acc[ai][bj][m][n] * r; f32x4 o;
#pragma unroll
                    for (int e = 0; e < 4; ++e) { const float lb = lbv[bj][n][e]; const float sg = __builtin_amdgcn_rcpf(1.f + __expf(-v[e])); o[e] = lb + (1.f - lb) * sg; }
                    at<f16x4>(LOGF, (row * D + cb + bj * 128 + n * 4) * 2u) = __builtin_convertvector(o, f16x4); }
                EPI_FENCE(); }
        } else if (part == 2) {
            FOR_AM { const unsigned row = rb + ai * 128 + m * 16; const float r = rr[ai][m];
                FOR_BJ { at<u32x4>(RI, (row * D + cb + bj * 128) * 2u) = pk8(acc[ai][bj][m][0] * r, acc[ai][bj][m][1] * r); }
                EPI_FENCE(); }
        } else {
            bf16* dst = part == 0 ? RQ : RG;
            FOR_AM { const unsigned row = rb + ai * 128 + m * 16; const float r = rr[ai][m];
                FOR_BJ { f32x4 v0 = acc[ai][bj][m][0] * r, v1 = acc[ai][bj][m][1] * r;
#pragma unroll
                    for (int e = 0; e < 4; ++e) { v0[e] = silu_f(v0[e]); v1[e] = silu_f(v1[e]); }
                    at<u32x4>(dst, (row * D + cb + bj * 128) * 2u) = pk8(v0, v1); }
                EPI_FENCE(); }
        }
    }
};
struct EpiQ { bf16* Q; const float* ssq; float scale;
    __device__ __forceinline__ void operator()(EPI_ARGS) const {
        const unsigned rb = u.row0 + wr * 64 + fr, cb = u.col0 + wc * 32 + 8 * fq;
        FOR_AM { const unsigned row = rb + ai * 128 + m * 16; const float r = ssq_rstd(ssq, row) * scale;
            FOR_BN { at<u32x2>(Q, (row * D + cb + bj * 128 + n * 4) * 2u) = pk4(acc[ai][bj][m][n] * r); }
            EPI_FENCE(); }
    }
};
struct EpiKV { float* outK; float* outV; bf16* MK; bf16* VT; const float* mssq;
    __device__ __forceinline__ void operator()(EPI_ARGS) const {
        const unsigned rb = u.row0 + wr * 64 + fr, cb = (u.col0 & (D - 1)) + wc * 32 + 8 * fq; const bool isK = u.col0 < D;
        float rr[2][4]; FOR_AM rr[ai][m] = rsqrtf(atc<float>(mssq, (rb + ai * 128 + m * 16) * 4u) * (1.f / D) + EPS);
        FOR_AM { const unsigned row = rb + ai * 128 + m * 16; const float r = rr[ai][m];
            FOR_BJ { const unsigned col = cb + bj * 128; const f32x4 v0 = acc[ai][bj][m][0] * r, v1 = acc[ai][bj][m][1] * r;
                float* of = isK ? outK : outV; bf16* ob = isK ? MK : VT;
                at<f32x4>(of, (row * D + col) * 4u) = v0; at<f32x4>(of, (row * D + col) * 4u + 16u) = v1; at<u32x4>(ob, (row * D + col) * 2u) = pk8(v0, v1); }
            EPI_FENCE(); }
    }
};
struct EpiSoftmax { bf16* P; LAS float* scr; const float* ssq;
    __device__ __forceinline__ void operator()(EPI_ARGS) const {
        LAS float* mx = scr; LAS float* sm = scr + 1024;
        const unsigned rl0 = wr * 64 + fr, cb = u.col0 + wc * 32 + 8 * fq;
        { LOAD_RSTD(s1, ssq, u.row0 + rl0);
        FOR_AM { const unsigned rl = rl0 + ai * 128 + m * 16; const float sc = s1[ai][m] * QSCALE; float v = -3.0e38f;
            FOR_BN { const f32x4 a = acc[ai][bj][m][n]; v = fmaxf(v, fmaxf(fmaxf(a[0], a[1]), fmaxf(a[2], a[3]))); }
            v *= sc;
            v = fmaxf(v, __shfl_xor(v, 16)); v = fmaxf(v, __shfl_xor(v, 32));
            if (fq == 0) mx[rl * 4 + wc] = v; } }
        LDS_WAIT(); __builtin_amdgcn_s_barrier(); asm volatile("" ::: "memory");
        { LOAD_RSTD(s2, ssq, u.row0 + rl0);
        FOR_AM { const unsigned rl = rl0 + ai * 128 + m * 16; const float sc = s2[ai][m] * QSCALE;
            const f32x4 q = *(LAS f32x4*)(mx + rl * 4); const float M = fmaxf(fmaxf(q[0], q[1]), fmaxf(q[2], q[3]));
            float s = 0.f;
            FOR_BN { const f32x4 a = acc[ai][bj][m][n] * sc; s += (__builtin_amdgcn_exp2f(a[0] - M) + __builtin_amdgcn_exp2f(a[1] - M)) + (__builtin_amdgcn_exp2f(a[2] - M) + __builtin_amdgcn_exp2f(a[3] - M)); }
            s += __shfl_xor(s, 16); s += __shfl_xor(s, 32);
            if (fq == 0) sm[rl * 4 + wc] = s; EPI_FENCE(); } }
        LDS_WAIT(); __builtin_amdgcn_s_barrier(); asm volatile("" ::: "memory");
        { LOAD_RSTD(s3, ssq, u.row0 + rl0);
        FOR_AM { const unsigned rl = rl0 + ai * 128 + m * 16; const float sc = s3[ai][m] * QSCALE;
            const f32x4 q = *(LAS f32x4*)(sm + rl * 4); const float inv = __builtin_amdgcn_rcpf((q[0] + q[1]) + (q[2] + q[3]));
            const f32x4 qm = *(LAS f32x4*)(mx + rl * 4); const float M = fmaxf(fmaxf(qm[0], qm[1]), fmaxf(qm[2], qm[3]));
            FOR_BJ { f32x4 pv[2];
#pragma unroll
                for (int n = 0; n < 2; ++n) { const f32x4 a = acc[ai][bj][m][n] * sc; pv[n] = (f32x4){__builtin_amdgcn_exp2f(a[0] - M) * inv, __builtin_amdgcn_exp2f(a[1] - M) * inv, __builtin_amdgcn_exp2f(a[2] - M) * inv, __builtin_amdgcn_exp2f(a[3] - M) * inv}; }
                at<u32x4>(P, ((u.row0 + rl) * D + cb + bj * 128) * 2u) = pk8(pv[0], pv[1]); }
            EPI_FENCE(); } }
    }
};
struct EpiPlain { bf16* O; unsigned pitch;
    __device__ __forceinline__ void operator()(EPI_ARGS) const {
        const unsigned rb = u.row0 + wr * 64 + fr, cb = u.col0 + wc * 32 + 8 * fq;
        FOR_AM { const unsigned row = rb + ai * 128 + m * 16;
            FOR_BJ { at<u32x4>(O, (row * pitch + cb + bj * 128) * 2u) = pk8(acc[ai][bj][m][0], acc[ai][bj][m][1]); }
            EPI_FENCE(); }
    }
};

}

__device__ __forceinline__ void transpose_item(const float* W, int K, int N, const float* gain, bf16* WT, int k0, int n0, int orow0, LAS float* scr, int lane) {
    f32x4 v[16]; const int kr = lane >> 4, c4 = (lane & 15) * 4;
#pragma unroll
    for (int i = 0; i < 16; ++i) v[i] = __builtin_nontemporal_load((const f32x4*)(W + (size_t)(k0 + 4 * i + kr) * N + n0 + c4));
#pragma unroll
    for (int i = 0; i < 16; ++i) { const int kk = 4 * i + kr; const float g = gain ? gain[k0 + kk] : 1.f; LAS float* d = scr + kk * 65 + c4;
        d[0] = v[i][0] * g; d[1] = v[i][1] * g; d[2] = v[i][2] * g; d[3] = v[i][3] * g; }
    LDS_WAIT(); asm volatile("" ::: "memory");
    const int c = lane & 7;
#pragma unroll
    for (int j = 0; j < 8; ++j) { const int n = (lane >> 3) + 8 * j; const LAS float* s = scr + (8 * c) * 65 + n;
        u32x4 o; o.x = pk2(s[0 * 65], s[1 * 65]); o.y = pk2(s[2 * 65], s[3 * 65]); o.z = pk2(s[4 * 65], s[5 * 65]); o.w = pk2(s[6 * 65], s[7 * 65]);
        *(u32x4*)(WT + (size_t)(orow0 + n) * K + k0 + 8 * c) = o; }
    LDS_WAIT(); asm volatile("" ::: "memory");
}

struct Args { const float* in[29]; float* out; unsigned char* ws; int ph_lo, ph_hi; };

__device__ __forceinline__ int map_row(int map, int n0) {
    if (map == 1) return (n0 >> 7) * 256 + (n0 & 127);
    if (map == 2) return (n0 >> 7) * 256 + 128 + (n0 & 127);
    if (map == 3) { if (n0 < D) return n0; if (n0 < 2 * D) { const int j = n0 - D; return D + (j >> 7) * 256 + (j & 127); } const int j = n0 - 2 * D; return D + (j >> 7) * 256 + 128 + (j & 127); }
    return n0;
}

__device__ __forceinline__ void prologue(const Args& a, const int z, LAS unsigned char* lds, int vcu, int G) {
    const int tid = otid(), lane = tid & 63, wave = tid >> 6;
    const int gw = vcu * NWAVES + wave, NGW = G * NWAVES;
    unsigned char* ws = a.ws + z;
    LAS float* scr = (LAS float*)(lds + wave * 16640);
    int off = 0;
    for (int job = 0; job < 26; ++job) {
        const float* W; const float* gain = nullptr; bf16* dst; int K = D, N = D, map = 0;
        if (job < 18) { const int li = job / 9, j = job % 9;
            switch (j) {
                case 0: W = a.in[8 + z] + (size_t)li * D * FF; gain = a.in[7 + z] + li * D; dst = (bf16*)(ws + WS_WGU + (size_t)(li * 2 + 0) * SZ_WGU); N = FF; map = 1; break;
                case 1: W = a.in[9 + z] + (size_t)li * D * FF; gain = a.in[7 + z] + li * D; dst = (bf16*)(ws + WS_WGU + (size_t)(li * 2 + 0) * SZ_WGU); N = FF; map = 2; break;
                case 2: W = a.in[10 + z] + (size_t)li * D * FF; dst = (bf16*)(ws + WS_WD + (size_t)(li * 2 + 0) * SZ_WD); K = FF; break;
                case 3: W = a.in[25 + z] + (size_t)li * D * FF; gain = a.in[24 + z] + li * D; dst = (bf16*)(ws + WS_WGU + (size_t)(li * 2 + 1) * SZ_WGU); N = FF; map = 1; break;
                case 4: W = a.in[26 + z] + (size_t)li * D * FF; gain = a.in[24 + z] + li * D; dst = (bf16*)(ws + WS_WGU + (size_t)(li * 2 + 1) * SZ_WGU); N = FF; map = 2; break;
                case 5: W = a.in[27 + z] + (size_t)li * D * FF; dst = (bf16*)(ws + WS_WD + (size_t)(li * 2 + 1) * SZ_WD); K = FF; break;
                case 6: W = a.in[21 + z] + (size_t)li * D * D; gain = a.in[19 + z] + li * D; dst = (bf16*)(ws + WS_WQ + (size_t)li * SZ_DD); break;
                case 7: W = a.in[22 + z] + (size_t)li * D * 2 * D; gain = a.in[20 + z] + li * D; dst = (bf16*)(ws + WS_WKV + (size_t)li * 2 * SZ_DD); N = 2 * D; break;
                default: W = a.in[23 + z] + (size_t)li * D * D; dst = (bf16*)(ws + WS_WO + (size_t)li * SZ_DD); break;
            }
        } else {
            switch (job) {
                case 18: W = a.in[12 + z]; gain = a.in[11 + z]; dst = (bf16*)(ws + WS_WCI); N = 3 * D; map = 3; break;
                case 19: W = a.in[14 + z]; dst = (bf16*)(ws + WS_WMO); break;
                case 20: W = a.in[16 + z]; gain = a.in[11 + z] + D; dst = (bf16*)(ws + WS_WRI); N = 4 * D; break;
                case 21: W = a.in[18 + z]; dst = (bf16*)(ws + WS_WMO + SZ_DD); break;
                default: W = nullptr; dst = nullptr; break;
            }
        }
        if (!W) continue;
        const int nblk = N / 64, nit = (K / 64) * nblk;
#pragma unroll 1
        for (int it = (gw - off + NGW) % NGW; it < nit; it += NGW) { const int kb = it / nblk, nb = it % nblk;
            transpose_item(W, K, N, gain, dst, kb * 64, nb * 64, map_row(map, nb * 64), scr, lane); }
        off = (off + nit) % NGW;
    }
    bf16* XB = (bf16*)(ws + WS_XB); float* SSQ = (float*)(ws + WS_SSQ);
#pragma unroll 1
    for (int m = gw; m < MT; m += 2 * NGW) {
        const int m2 = m + NGW; const bool has2 = m2 < MT;
        const f32x4* xr = (const f32x4*)(m < MP ? a.in[0 + z] + (size_t)m * D : a.in[1 + z] + (size_t)(m - MP) * D) + lane;
        const f32x4* xr2 = (const f32x4*)(!has2 ? (const float*)xr - 4 * lane : (m2 < MP ? a.in[0 + z] + (size_t)m2 * D : a.in[1 + z] + (size_t)(m2 - MP) * D)) + lane;
        f32x4 v[4], v2[4];
#pragma unroll
        for (int j = 0; j < 4; ++j) { v[j] = __builtin_nontemporal_load(xr + 64 * j); v2[j] = __builtin_nontemporal_load(xr2 + 64 * j); }
        float s = 0.f, s2 = 0.f;
#pragma unroll
        for (int j = 0; j < 4; ++j) { s += (v[j][0] * v[j][0] + v[j][1] * v[j][1]) + (v[j][2] * v[j][2] + v[j][3] * v[j][3]); s2 += (v2[j][0] * v2[j][0] + v2[j][1] * v2[j][1]) + (v2[j][2] * v2[j][2] + v2[j][3] * v2[j][3]);
            ((u32x2*)(XB + (size_t)m * D))[lane + 64 * j] = pg8::pk4(v[j]); if (has2) ((u32x2*)(XB + (size_t)m2 * D))[lane + 64 * j] = pg8::pk4(v2[j]); }
        s = wave_sum(s); s2 = wave_sum(s2); if (lane == 0) { ((unsigned*)SSQ)[m] = (unsigned)(s * pg8::SSQ_FX + 0.5f); if (has2) ((unsigned*)SSQ)[m2] = (unsigned)(s2 * pg8::SSQ_FX + 0.5f); }
    }
    for (int i = gw * 64 + lane; i < 2 * D * D / 8; i += NGW * 64) { const int l = i >> 17, e0 = (i & 131071) * 8, kk = e0 >> 10;
        const float g = a.in[19 + z][l * D + kk]; const f32x4* p = (const f32x4*)(a.in[21 + z] + (size_t)l * D * D + e0); const f32x4 v0 = p[0] * g, v1 = p[1] * g;
        u32x4 o; o.x = pk2(v0[0], v0[1]); o.y = pk2(v0[2], v0[3]); o.z = pk2(v1[0], v1[1]); o.w = pk2(v1[2], v1[3]);
        *(u32x4*)((bf16*)(ws + WS_WQN) + (size_t)l * D * D + e0) = o; }
    bf16* MEMB = (bf16*)(ws + WS_MEMB); float* MSSQ = (float*)(ws + WS_MSSQ);
    for (int m = gw; m < MEMR; m += NGW) { const f32x4* xr = (const f32x4*)(a.in[2 + z] + (size_t)m * D) + lane; float s = 0.f;
#pragma unroll
        for (int j = 0; j < 4; ++j) { const f32x4 v = xr[64 * j]; s += (v[0] * v[0] + v[1] * v[1]) + (v[2] * v[2] + v[3] * v[3]); u32x2 w; w.x = pk2(v[0], v[1]); w.y = pk2(v[2], v[3]); ((u32x2*)(MEMB + (size_t)m * D))[lane + 64 * j] = w; }
        s = wave_sum(s); if (lane == 0) MSSQ[m] = s; }
    for (int i = vcu * NTHR + tid; i < 8 * MPAD; i += G * NTHR) SSQ[MPAD + i] = 0.f;
}

__device__ __forceinline__ void ld8(const bf16* p, float (&f)[8]) { const u32x4 w = *(const u32x4*)p; f[0] = bflo(w.x); f[1] = bfhi(w.x); f[2] = bflo(w.y); f[3] = bfhi(w.y); f[4] = bflo(w.z); f[5] = bfhi(w.z); f[6] = bflo(w.w); f[7] = bfhi(w.w); }
__device__ __forceinline__ void up8(const u32x4 w, float (&f)[8]) { f[0] = bflo(w.x); f[1] = bfhi(w.x); f[2] = bflo(w.y); f[3] = bfhi(w.y); f[4] = bflo(w.z); f[5] = bfhi(w.z); f[6] = bflo(w.w); f[7] = bfhi(w.w); }
__device__ __forceinline__ void conv_phase(const Args& a, const int z, int vcu, int G) {
    unsigned char* ws = a.ws + z; const bf16* CB = (const bf16*)(ws + WS_M1); const bf16* CV = (const bf16*)(ws + WS_M2); bf16* Gb = (bf16*)(ws + WS_G);
    const float* wc = a.in[13 + z]; const float* st = a.in[3 + z]; float* out_cs = a.out + OUT_CS;
    const int nth = G * NTHR, gt = vcu * NTHR + otid(), ch = (gt & 127) * 8;
    float w0[8], w1[8], w2[8];
#pragma unroll
    for (int e = 0; e < 8; ++e) { w0[e] = wc[ch + e]; w1[e] = wc[D + ch + e]; w2[e] = wc[2 * D + ch + e]; }
    if ((nth & 127) == 0) {
#pragma unroll 1
        for (int it0 = gt; it0 < MP * 128; it0 += 4 * nth) {
            u32x4 B[4], V2[4], V1[4], V0[4];
#pragma unroll
            for (int j = 0; j < 4; ++j) { const int it = it0 + j * nth; const int row = it < MP * 128 ? (it >> 7) : 0; const int t = row & (T - 1);
                B[j] = *(const u32x4*)(CB + (size_t)row * D + ch); V2[j] = *(const u32x4*)(CV + (size_t)row * D + ch);
                V1[j] = *(const u32x4*)(CV + (size_t)(row - (t >= 1 ? 1 : 0)) * D + ch); V0[j] = *(const u32x4*)(CV + (size_t)(row - (t >= 2 ? 2 : 0)) * D + ch); }
#pragma unroll
            for (int j = 0; j < 4; ++j) { const int it = it0 + j * nth; if (it < MP * 128) { const int row = it >> 7, t = row & (T - 1);
                float b[8], v2[8], v1[8], v0[8], g[8]; up8(B[j], b); up8(V2[j], v2); up8(V1[j], v1); up8(V0[j], v0);
                const float m1 = t >= 1 ? 1.f : 0.f, m0 = t >= 2 ? 1.f : 0.f;
#pragma unroll
                for (int e = 0; e < 8; ++e) g[e] = b[e] * (w0[e] * (v0[e] * m0) + w1[e] * (v1[e] * m1) + w2[e] * v2[e]);
                u32x4 w; w.x = pk2(g[0], g[1]); w.y = pk2(g[2], g[3]); w.z = pk2(g[4], g[5]); w.w = pk2(g[6], g[7]);
                *(u32x4*)(Gb + (size_t)row * D + ch) = w; } }
        }
        if (gt < NS * 128) { const int s = gt >> 7, row = MP + s; float b[8], v2[8], g[8];
            ld8(CB + (size_t)row * D + ch, b); ld8(CV + (size_t)row * D + ch, v2);
            const f32x4* p0 = (const f32x4*)(st + ((size_t)s * 2 + 0) * D + ch); const f32x4* p1 = (const f32x4*)(st + ((size_t)s * 2 + 1) * D + ch);
            const f32x4 a0 = p0[0], a1 = p0[1], b0 = p1[0], b1 = p1[1];
            f32x4* o = (f32x4*)(out_cs + ((size_t)s * 2 + 0) * D + ch); o[0] = b0; o[1] = b1;
#pragma unroll
            for (int e = 0; e < 8; ++e) { const float x0 = e < 4 ? a0[e & 3] : a1[e & 3], x1 = e < 4 ? b0[e & 3] : b1[e & 3]; g[e] = b[e] * (w0[e] * x0 + w1[e] * x1 + w2[e] * v2[e]); }
            u32x4 w; w.x = pk2(g[0], g[1]); w.y = pk2(g[2], g[3]); w.z = pk2(g[4], g[5]); w.w = pk2(g[6], g[7]);
            *(u32x4*)(Gb + (size_t)row * D + ch) = w; }
        return;
    }
    for (int it = gt; it < MT * 128; it += nth) {
        const int row = it >> 7, chx = (it & 127) * 8; float b[8], v2[8], v1[8], v0[8];
        ld8(CB + (size_t)row * D + chx, b); ld8(CV + (size_t)row * D + chx, v2);
        if (row < MP) { const int t = row & (T - 1);
            if (t >= 1) ld8(CV + (size_t)(row - 1) * D + chx, v1); else { for (int e = 0; e < 8; ++e) v1[e] = 0.f; }
            if (t >= 2) ld8(CV + (size_t)(row - 2) * D + chx, v0); else { for (int e = 0; e < 8; ++e) v0[e] = 0.f; }
        } else { const int s = row - MP; const f32x4* p0 = (const f32x4*)(st + ((size_t)s * 2 + 0) * D + chx); const f32x4* p1 = (const f32x4*)(st + ((size_t)s * 2 + 1) * D + chx);
            const f32x4 a0 = p0[0], a1 = p0[1], b0 = p1[0], b1 = p1[1];
            for (int e = 0; e < 4; ++e) { v0[e] = a0[e]; v0[4 + e] = a1[e]; v1[e] = b0[e]; v1[4 + e] = b1[e]; }
            f32x4* o = (f32x4*)(out_cs + ((size_t)s * 2 + 0) * D + chx); o[0] = b0; o[1] = b1; }
        float g[8];
#pragma unroll
        for (int e = 0; e < 8; ++e) g[e] = b[e] * (wc[chx + e] * v0[e] + wc[D + chx + e] * v1[e] + wc[2 * D + chx + e] * v2[e]);
        u32x4 w; w.x = pk2(g[0], g[1]); w.y = pk2(g[2], g[3]); w.z = pk2(g[4], g[5]); w.w = pk2(g[6], g[7]);
        *(u32x4*)(Gb + (size_t)row * D + chx) = w;
    }
}

__device__ __forceinline__ void sample_attn_unit(LAS unsigned char* lds, const float* Kc, const float* Vc, const bf16* Q, bf16* O, int s, int hp) {
    const int tid = otid(), lane = tid & 63, w = tid >> 6;
    LAS float* qs = (LAS float*)lds; LAS float* sc = qs + 512; LAS float* red = sc + 512;
    qs[tid] = bf2f(Q[(size_t)(MP + s) * D + hp * 512 + tid]);
    __syncthreads();
    const f32x4 qa = *(LAS f32x4*)(qs + 4 * lane), qb = *(LAS f32x4*)(qs + 256 + 4 * lane);
    const float* Kb = Kc + ((size_t)s * NMEM * 4 + hp * 2) * 256 + 4 * lane;
    for (int j = 0; j < 32; j += 8) {
        f32x4 ka[8], kb[8];
#pragma unroll
        for (int jj = 0; jj < 8; ++jj) { const int n = w + 8 * (j + jj); ka[jj] = __builtin_nontemporal_load((const f32x4*)(Kb + (size_t)n * 1024)); kb[jj] = __builtin_nontemporal_load((const f32x4*)(Kb + (size_t)n * 1024 + 256)); }
#pragma unroll
        for (int jj = 0; jj < 8; ++jj) { const int n = w + 8 * (j + jj);
            float pa = (qa[0] * ka[jj][0] + qa[1] * ka[jj][1]) + (qa[2] * ka[jj][2] + qa[3] * ka[jj][3]);
            float pb = (qb[0] * kb[jj][0] + qb[1] * kb[jj][1]) + (qb[2] * kb[jj][2] + qb[3] * kb[jj][3]);
            pa = wave_sum(pa); pb = wave_sum(pb);
            if (lane == 0) { sc[n] = pa; sc[256 + n] = pb; } }
    }
    __syncthreads();
    if (w < 2) { LAS float* p = sc + 256 * w; float v[4]; float m = -3.0e38f;
#pragma unroll
        for (int i = 0; i < 4; ++i) { v[i] = p[lane + 64 * i]; m = fmaxf(m, v[i]); }
        m = wave_max(m); float sum = 0.f;
#pragma unroll
        for (int i = 0; i < 4; ++i) { v[i] = __builtin_amdgcn_exp2f(v[i] - m); sum += v[i]; }
        sum = wave_sum(sum); const float inv = 1.f / sum;
#pragma unroll
        for (int i = 0; i < 4; ++i) p[lane + 64 * i] = v[i] * inv; }
    __syncthreads();
    const int dq = tid & 127, ng = tid >> 7, hsel = dq >> 6;
    const float* Vb = Vc + ((size_t)s * NMEM * 4 + hp * 2) * 256 + 4 * dq;
    f32x4 acc = (f32x4){0.f, 0.f, 0.f, 0.f};
#pragma unroll 16
    for (int j = 0; j < 64; ++j) { const int n = ng + 4 * j; const float p = sc[hsel * 256 + n]; const f32x4 v = __builtin_nontemporal_load((const f32x4*)(Vb + (size_t)n * 1024)); acc += v * p; }
    *(LAS f32x4*)(red + ng * 512 + 4 * dq) = acc;
    __syncthreads();
    if (tid < 128) { f32x4 o = *(LAS f32x4*)(red + 4 * tid) + *(LAS f32x4*)(red + 512 + 4 * tid) + *(LAS f32x4*)(red + 1024 + 4 * tid) + *(LAS f32x4*)(red + 1536 + 4 * tid);
        u32x2 wv; wv.x = pk2(o[0], o[1]); wv.y = pk2(o[2], o[3]); *(u32x2*)(O + (size_t)(MP + s) * D + hp * 512 + 4 * tid) = wv; }
    __syncthreads();
}

__device__ __forceinline__ void sample_rec_unit(LAS unsigned char* lds, const Args& a, const int z, int s, int h) {
    const int tid = otid(), lane = tid & 63, w = tid >> 6;
    unsigned char* ws = a.ws + z; const bf16* RQ = (const bf16*)(ws + WS_M1); const bf16* RI = (const bf16*)(ws + WS_M2); const bf16* RG = (const bf16*)(ws + WS_RG); const _Float16* LOGF = (const _Float16*)(ws + WS_LOGF);
    bf16* GO = (bf16*)(ws + WS_G);
    LAS float* fL = (LAS float*)lds; LAS float* kL = fL + 128; LAS float* qL = kL + 128; LAS float* iL = qL + 128; LAS float* red = iL + 128; LAS float* tmp = red + 16 * 128;
    const size_t rbase = (size_t)(MP + s) * D + h * 128;
    if (tid < 128) { const float f = (float)LOGF[rbase + tid]; fL[tid] = f; kL[tid] = 1.f - f; qL[tid] = bf2f(RQ[rbase + tid]); iL[tid] = bf2f(RI[rbase + tid]); }
    __syncthreads();
    const int vq = tid & 31, kq = tid >> 5;
    const f32x4 iv = *(LAS f32x4*)(iL + 4 * vq); f32x4 o = (f32x4){0.f, 0.f, 0.f, 0.f};
    const size_t sb = ((size_t)(s * 8 + h) * 128) * 128;
    const float* S0 = a.in[4 + z] + sb; float* So = a.out + OUT_RS + sb;
    f32x4 s0v[8];
#pragma unroll
    for (int j = 0; j < 8; ++j) s0v[j] = __builtin_nontemporal_load((const f32x4*)(S0 + (kq + 16 * j) * 128 + 4 * vq));
#pragma unroll
    for (int j = 0; j < 8; ++j) { const int k = kq + 16 * j; const f32x4 sn = s0v[j] * fL[k] + iv * kL[k];
        *(f32x4*)(So + k * 128 + 4 * vq) = sn; o += sn * qL[k]; }
    *(LAS f32x4*)(red + kq * 128 + 4 * vq) = o;
    __syncthreads();
    float ov = 0.f;
    if (tid < 128) {
#pragma unroll
        for (int j = 0; j < 16; ++j) ov += red[j * 128 + tid];
        const float ss = wave_sum(ov * ov); if (lane == 0) tmp[w] = ss; }
    __syncthreads();
    if (tid < 128) { const float rstd = rsqrtf((tmp[0] + tmp[1]) * (1.f / 128.f) + EPS);
        GO[rbase + tid] = (bf16)f2bf(ov * rstd * a.in[17 + z][tid] * bf2f(RG[rbase + tid])); }
    __syncthreads();
}

__device__ __forceinline__ f32x4 mfma16(bf16x8 a, bf16x8 b, f32x4 c) { return __builtin_amdgcn_mfma_f32_16x16x32_bf16(a, b, c, 0, 0, 0); }
constexpr int G1_QB = 0, G1_KI = 17408, G1_KL = 34816, G1_VT = 53248, G1_AT = 71680, G1_TOT = 80896;
struct G1In { float f[16]; unsigned q[16]; unsigned v[16]; };
__device__ __forceinline__ void gla_g1_load(unsigned char* ws, int unit, int tid, G1In& in) {
    const _Float16* FG = (const _Float16*)(ws + WS_LOGF); const bf16* RQ = (const bf16*)(ws + WS_M1); const bf16* RI = (const bf16*)(ws + WS_M2);
    const int bh = unit >> 5, c = unit & 31, b = bh >> 3, h = bh & 7, row0 = b * T + c * 64;
    const size_t gb = (size_t)(row0 + 16 * (tid >> 7)) * D + h * 128 + (tid & 127);
#pragma unroll
    for (int j = 0; j < 16; ++j) { in.f[j] = (float)FG[gb + (size_t)j * D]; in.q[j] = RQ[gb + (size_t)j * D]; in.v[j] = RI[gb + (size_t)j * D]; }
}
#define G1_BAR() do { LDS_WAIT(); __builtin_amdgcn_s_barrier(); asm volatile("" ::: "memory"); } while (0)
__device__ __forceinline__ void gla_g1_compute(LAS unsigned char* lds, unsigned char* ws, int unit, int tid, const G1In& in) {
    const int lane = tid & 63, w = tid >> 6, r = lane & 15, q = lane >> 4;
    bf16* QBG = (bf16*)(ws + WS_QBG); bf16* OINTRA = (bf16*)(ws + WS_OINTRA); bf16* UT = (bf16*)(ws + WS_UT); float* DEC = (float*)(ws + WS_DEC);
    const int bh = unit >> 5, c = unit & 31, b = bh >> 3, h = bh & 7, row0 = b * T + c * 64, colh = h * 128;
    LAS bf16* QbL = (LAS bf16*)(lds + G1_QB); LAS bf16* KiL = (LAS bf16*)(lds + G1_KI); LAS bf16* KlT = (LAS bf16*)(lds + G1_KL); LAS bf16* vT = (LAS bf16*)(lds + G1_VT); LAS bf16* atL = (LAS bf16*)(lds + G1_AT);
    LAS float* tot = (LAS float*)(lds + G1_TOT);
    const int k = tid & 127, part = tid >> 7, t0 = 16 * part;
    float pc[16]; float run = 1.f;
#pragma unroll
    for (int j = 0; j < 16; ++j) { run *= in.f[j]; pc[j] = run; }
    tot[part * 128 + k] = run;
    G1_BAR();
    float offp = 1.f, eL = 1.f;
#pragma unroll
    for (int p = 0; p < 4; ++p) { const float tv = tot[p * 128 + k]; eL *= tv; if (p < part) offp *= tv; }
    unsigned kl[8];
#pragma unroll
    for (int j = 0; j < 16; j += 2) {
        const float e0 = pc[j] * offp, e1 = pc[j + 1] * offp, i0 = __builtin_amdgcn_rcpf(e0), i1 = __builtin_amdgcn_rcpf(e1);
        const float ki0 = (1.f - in.f[j]) * i0, ki1 = (1.f - in.f[j + 1]) * i1;
        const unsigned qb = pk2(bf2f(in.q[j]) * e0, bf2f(in.q[j + 1]) * e1), ki = pk2(ki0, ki1);
        QbL[(t0 + j) * 136 + k] = (bf16)(qb & 0xffffu); QbL[(t0 + j + 1) * 136 + k] = (bf16)(qb >> 16);
        KiL[(t0 + j) * 136 + k] = (bf16)(ki & 0xffffu); KiL[(t0 + j + 1) * 136 + k] = (bf16)(ki >> 16);
        kl[j >> 1] = pk2(ki0 * eL, ki1 * eL); }
    { u32x4 w0, w1; w0.x = kl[0]; w0.y = kl[1]; w0.z = kl[2]; w0.w = kl[3]; w1.x = kl[4]; w1.y = kl[5]; w1.z = kl[6]; w1.w = kl[7];
      *(LAS u32x4*)(KlT + k * 72 + t0) = w0; *(LAS u32x4*)(KlT + k * 72 + t0 + 8) = w1;
      w0.x = in.v[0] | (in.v[1] << 16); w0.y = in.v[2] | (in.v[3] << 16); w0.z = in.v[4] | (in.v[5] << 16); w0.w = in.v[6] | (in.v[7] << 16);
      w1.x = in.v[8] | (in.v[9] << 16); w1.y = in.v[10] | (in.v[11] << 16); w1.z = in.v[12] | (in.v[13] << 16); w1.w = in.v[14] | (in.v[15] << 16);
      *(LAS u32x4*)(vT + k * 72 + t0) = w0; *(LAS u32x4*)(vT + k * 72 + t0 + 8) = w1; }
    if (part == 0) DEC[(size_t)unit * 128 + k] = eL;
    G1_BAR();
#pragma unroll
    for (int i = 0; i < 2; ++i) { const int idx = tid + 512 * i, t = idx >> 4, c16 = idx & 15; *(u32x4*)(QBG + (size_t)(row0 + t) * D + colh + 8 * c16) = *(const LAS u32x4*)(QbL + t * 136 + 8 * c16); }
    { const int ti = w >> 1;
#pragma unroll
      for (int sx = 0; sx < 2; ++sx) { const int sj = 2 * (w & 1) + sx; f32x4 acc = (f32x4){0.f, 0.f, 0.f, 0.f};
        if (sj <= ti) {
#pragma unroll
        for (int ks = 0; ks < 4; ++ks) { const bf16x8 av = *(const LAS bf16x8*)(QbL + (16 * ti + r) * 136 + 32 * ks + 8 * q); const bf16x8 bv = *(const LAS bf16x8*)(KiL + (16 * sj + r) * 136 + 32 * ks + 8 * q); acc = mfma16(av, bv, acc); } }
#pragma unroll
        for (int e = 0; e < 4; ++e) { const int t = 16 * ti + 4 * q + e, s = 16 * sj + r; atL[t * 72 + s] = (bf16)f2bf(s <= t ? acc[e] : 0.f); } } }
    G1_BAR();
    { const int tj = w & 3;
#pragma unroll
      for (int vx = 0; vx < 4; ++vx) { const int vi = 4 * (w >> 2) + vx; f32x4 acc = (f32x4){0.f, 0.f, 0.f, 0.f};
#pragma unroll
        for (int ks = 0; ks < 2; ++ks) { const bf16x8 av = *(const LAS bf16x8*)(vT + (16 * vi + r) * 72 + 32 * ks + 8 * q); const bf16x8 bv = *(const LAS bf16x8*)(atL + (16 * tj + r) * 72 + 32 * ks + 8 * q); acc = mfma16(av, bv, acc); }
        *(u32x2*)(OINTRA + (size_t)(row0 + 16 * tj + r) * D + colh + 16 * vi + 4 * q) = pg8::pk4(acc); } }
    { const int vj = w;
#pragma unroll
      for (int ki = 0; ki < 8; ++ki) { f32x4 acc = (f32x4){0.f, 0.f, 0.f, 0.f};
#pragma unroll
        for (int ks = 0; ks < 2; ++ks) { const bf16x8 av = *(const LAS bf16x8*)(KlT + (16 * ki + r) * 72 + 32 * ks + 8 * q); const bf16x8 bv = *(const LAS bf16x8*)(vT + (16 * vj + r) * 72 + 32 * ks + 8 * q); acc = mfma16(av, bv, acc); }
        *(u32x2*)(UT + (size_t)unit * 16384 + (size_t)(16 * vj + r) * 128 + 16 * ki + 4 * q) = pg8::pk4(acc); } }
    G1_BAR();
}
__device__ __forceinline__ void gla_g1_phase(LAS unsigned char* lds, unsigned char* ws, int bx, int G) {
    const int tid = otid(); G1In cur, nxt;
    if (bx < 2048) gla_g1_load(ws, bx, tid, cur);
#pragma unroll 1
    for (int u = bx; u < 2048; u += G) { const int un = u + G;
        if (un < 2048) gla_g1_load(ws, un, tid, nxt);
        gla_g1_compute(lds, ws, u, tid, cur);
        cur = nxt; }
    asm volatile("s_waitcnt vmcnt(0)" ::: "memory"); __syncthreads();
}
__device__ __forceinline__ void gla_g2(const Args& a, const int z, int vcu, int G) {
    unsigned char* ws = a.ws + z; const bf16* UT = (const bf16*)(ws + WS_UT); const float* DEC = (const float*)(ws + WS_DEC); bf16* SPT = (bf16*)(ws + WS_SPT); float* outp = a.out + OUT_RP;
    for (int it = vcu * NTHR + otid(); it < 64 * 128 * 32; it += G * NTHR) {
        const int k4 = it & 31, v = (it >> 5) & 127, bh = it >> 12; f32x4 S = (f32x4){0.f, 0.f, 0.f, 0.f};
        const size_t eo = (size_t)v * 128 + 4 * k4;
#pragma unroll 1
        for (int c0 = 0; c0 < 32; c0 += 8) { u32x2 uw[8]; f32x4 dd[8];
#pragma unroll
            for (int j = 0; j < 8; ++j) { const size_t unit = (size_t)bh * 32 + c0 + j; uw[j] = *(const u32x2*)(UT + unit * 16384 + eo); dd[j] = *(const f32x4*)(DEC + unit * 128 + 4 * k4); }
#pragma unroll
            for (int j = 0; j < 8; ++j) { const size_t unit = (size_t)bh * 32 + c0 + j; const f32x4 uu = (f32x4){bflo(uw[j].x), bfhi(uw[j].x), bflo(uw[j].y), bfhi(uw[j].y)};
                u32x2 wv; wv.x = pk2(S[0], S[1]); wv.y = pk2(S[2], S[3]); *(u32x2*)(SPT + unit * 16384 + eo) = wv;
                S = S * dd[j] + uu; } }
#pragma unroll
        for (int e = 0; e < 4; ++e) outp[((size_t)bh * 128 + 4 * k4 + e) * 128 + v] = S[e];
    }
}
__device__ __forceinline__ void gla_g3_phase(LAS unsigned char* lds, const Args& a, const int z, int bx, int G) {
    const int tid = otid(), lane = tid & 63, w = tid >> 6, r = lane & 15, q = lane >> 4;
    unsigned char* ws = a.ws + z; const bf16* QBG = (const bf16*)(ws + WS_QBG); const bf16* SPT = (const bf16*)(ws + WS_SPT); const bf16* OINTRA = (const bf16*)(ws + WS_OINTRA);
    const bf16* RG = (const bf16*)(ws + WS_RG); bf16* GO = (bf16*)(ws + WS_G); const float* gon = a.in[17 + z];
    constexpr int BUFB = 17408 + 34816 + 512;
    u32x4 pq[2], ps[4];
    { const int u = bx, bh = u >> 5, c = u & 31, row0 = (bh >> 3) * T + c * 64, colh = (bh & 7) * 128;
#pragma unroll
      for (int i = 0; i < 2; ++i) { const int idx = tid + 512 * i; pq[i] = *(const u32x4*)(QBG + (size_t)(row0 + (idx >> 4)) * D + colh + 8 * (idx & 15)); }
#pragma unroll
      for (int i = 0; i < 4; ++i) { const int idx = tid + 512 * i; ps[i] = *(const u32x4*)(SPT + (size_t)u * 16384 + (idx >> 4) * 128 + 8 * (idx & 15)); } }
    int par = 0;
#pragma unroll 1
    for (int u = bx; u < 2048; u += G, par ^= 1) {
        LAS bf16* QbL = (LAS bf16*)(lds + par * BUFB); LAS bf16* SL = (LAS bf16*)(lds + par * BUFB + 17408); LAS float* ssL = (LAS float*)(lds + par * BUFB + 17408 + 34816);
        const int bh = u >> 5, c = u & 31, row0 = (bh >> 3) * T + c * 64, colh = (bh & 7) * 128;
#pragma unroll
        for (int i = 0; i < 2; ++i) { const int idx = tid + 512 * i; *(LAS u32x4*)(QbL + (idx >> 4) * 136 + 8 * (idx & 15)) = pq[i]; }
#pragma unroll
        for (int i = 0; i < 4; ++i) { const int idx = tid + 512 * i; *(LAS u32x4*)(SL + (idx >> 4) * 136 + 8 * (idx & 15)) = ps[i]; }
        G1_BAR();
        const int un = u + G;
        if (un < 2048) { const int bh2 = un >> 5, c2 = un & 31, row2 = (bh2 >> 3) * T + c2 * 64, colh2 = (bh2 & 7) * 128;
#pragma unroll
            for (int i = 0; i < 2; ++i) { const int idx = tid + 512 * i; pq[i] = *(const u32x4*)(QBG + (size_t)(row2 + (idx >> 4)) * D + colh2 + 8 * (idx & 15)); }
#pragma unroll
            for (int i = 0; i < 4; ++i) { const int idx = tid + 512 * i; ps[i] = *(const u32x4*)(SPT + (size_t)un * 16384 + (idx >> 4) * 128 + 8 * (idx & 15)); } }
        const int tj = w & 3, vh = w >> 2, t = 16 * tj + r; f32x4 o[4]; float ss = 0.f;
        u32x2 ow[4], rg[4];
#pragma unroll
        for (int vx = 0; vx < 4; ++vx) { const size_t off = (size_t)(row0 + t) * D + colh + 16 * (4 * vh + vx) + 4 * q; ow[vx] = *(const u32x2*)(OINTRA + off); rg[vx] = *(const u32x2*)(RG + off); }
#pragma unroll
        for (int vx = 0; vx < 4; ++vx) { const int vi = 4 * vh + vx; f32x4 acc = (f32x4){bflo(ow[vx].x), bfhi(ow[vx].x), bflo(ow[vx].y), bfhi(ow[vx].y)};
#pragma unroll
            for (int ks = 0; ks < 4; ++ks) { const bf16x8 av = *(const LAS bf16x8*)(SL + (16 * vi + r) * 136 + 32 * ks + 8 * q); const bf16x8 bv = *(const LAS bf16x8*)(QbL + (16 * tj + r) * 136 + 32 * ks + 8 * q); acc = mfma16(av, bv, acc); }
            o[vx] = acc; ss += (acc[0] * acc[0] + acc[1] * acc[1]) + (acc[2] * acc[2] + acc[3] * acc[3]); }
        ss += __shfl_xor(ss, 16); ss += __shfl_xor(ss, 32);
        if (q == 0) ssL[vh * 64 + t] = ss;
        G1_BAR();
        const float rstd = rsqrtf((ssL[t] + ssL[64 + t]) * (1.f / 128.f) + EPS);
#pragma unroll
        for (int vx = 0; vx < 4; ++vx) { const int v0 = 16 * (4 * vh + vx) + 4 * q; const f32x4 gn = *(const f32x4*)(gon + v0); const size_t off = (size_t)(row0 + t) * D + colh + v0;
            u32x2 wv; wv.x = pk2(o[vx][0] * rstd * gn[0] * bflo(rg[vx].x), o[vx][1] * rstd * gn[1] * bfhi(rg[vx].x)); wv.y = pk2(o[vx][2] * rstd * gn[2] * bflo(rg[vx].y), o[vx][3] * rstd * gn[3] * bfhi(rg[vx].y));
            *(u32x2*)(GO + off) = wv; }
    }
    asm volatile("s_waitcnt vmcnt(0)" ::: "memory"); __syncthreads();
}

__device__ __forceinline__ int opaque_v0() { int z; asm volatile("v_mov_b32 %0, 0" : "=v"(z)); return z; }
__device__ __forceinline__ int opaque0() { int z; asm volatile("s_mov_b32 %0, 0" : "=s"(z)); return z; }
#define INP(i) (a.in[(i) + z])
constexpr int NSTEPS = 29;
struct GemmDesc { const char* A; const char* B; int lda, ldb, K, M, N; size_t bstride; };
__device__ __forceinline__ void gemm_desc(const Args& a, int gs, bool smp, GemmDesc& d) {
    unsigned char* ws = a.ws; const int li = gs >= 15 ? 1 : 0, st = gs - 2 - 13 * li;
    d.lda = D; d.ldb = D; d.K = D; d.M = MP; d.N = D; d.bstride = 0; d.A = (const char*)(ws + WS_XB);
    if (st == 0 || st == 11) { d.B = (const char*)(ws + WS_WGU + (size_t)(li * 2 + (st == 11)) * SZ_WGU); d.N = 2 * FF; d.M = MPAD; }
    else if (st == 1 || st == 12) { d.A = (const char*)(ws + WS_H); d.B = (const char*)(ws + WS_WD + (size_t)(li * 2 + (st == 12)) * SZ_WD); d.K = FF; d.lda = FF; d.ldb = FF; }
    else if (st == 2) { d.B = li == 0 ? (const char*)(ws + WS_WCI) : (const char*)(ws + WS_WRI); d.N = li == 0 ? 3 * D : 4 * D; }
    else if (st == 6) { d.A = (const char*)(ws + WS_G); d.B = (const char*)(ws + WS_WMO + (size_t)li * SZ_DD); }
    else if (st == 7) { if (smp) d.B = (const char*)(ws + WS_WQ + (size_t)li * SZ_DD); else { d.B = (const char*)(ws + WS_WQK + (size_t)li * 8 * SZ_DD); d.bstride = SZ_DD; } }
    else if (st == 8) { d.A = (const char*)(ws + WS_P); d.B = (const char*)(ws + WS_VWT + (size_t)li * 8 * SZ_DD); d.ldb = 8 * D; d.bstride = (size_t)D * 2; }
    else { d.A = (const char*)(ws + WS_O); d.B = (const char*)(ws + WS_WO + (size_t)li * SZ_DD); }
}
namespace pg8 {
struct SchedAny { const Args& a; int gs, G, c;
    __device__ __forceinline__ bool next(int i, Unit& u) const {
        const int g2 = gs + opaque0(); GemmDesc d; gemm_desc(a, g2, false, d);
        Sched2D s; s.A = d.A; s.B = d.B; s.bstride = d.bstride; s.lda = d.lda; s.ldb = d.ldb; s.nM = d.M / BM; s.nN = d.N / BM; s.nwg = s.nM * s.nN; s.G = G; s.c = c;
        u.nt = d.K / BK; u.kind = 0;
        const int j = i * G + c - s.nwg; unsigned char* ws = a.ws;
        if ((g2 == 2 || g2 == 13) && j >= 0 && j < 64) {
            const int pm = j & 7, pn = j >> 3;
            u.A = (const char*)(ws + WS_MEMB) + (size_t)pm * BM * D * 2; u.B = (const char*)(ws + WS_WKV + (size_t)(g2 == 13) * 2 * SZ_DD) + (size_t)pn * BM * D * 2;
            u.row0 = pm * BM; u.col0 = 8192 + pn * BM; return true; }
        if ((g2 == 4 || g2 == 17) && j >= 0 && j < 256) {
            const int l = g2 == 17, which = j >> 7, jj = j & 127, b = jj >> 4, h = (jj >> 2) & 3, t4 = jj & 3; u.nt = 4;
            if (which == 0) { u.kind = 1; u.A = (const char*)(ws + WS_MEMK + (size_t)l * MEMR * D * 2) + ((size_t)(b * NMEM) * D + h * 256) * 2; u.B = (const char*)(ws + WS_WQN + (size_t)l * SZ_DD) + ((size_t)(t4 * 256) * D + h * 256) * 2;
                u.row0 = b * 1024 + h * 256; u.col0 = t4 * 256; }
            else { u.kind = 2; u.A = (const char*)(ws + WS_WO + (size_t)l * SZ_DD) + ((size_t)(t4 * 256) * D + h * 256) * 2; u.B = (const char*)(ws + WS_VT + (size_t)l * MEMR * D * 2) + ((size_t)(b * NMEM) * D + h * 256) * 2;
                u.row0 = t4 * 256; u.col0 = b * 1024 + h * 256; }
            return true; }
        return s.next(i, u);
    }
};
struct EpiAny { const Args& a; int gs0; LAS float* scr;
    __device__ __forceinline__ void operator()(const Acc& acc, const Unit& u, int wr, int wc, int fr_, int fq_) const {
        const int ov = opaque_v0(); const int fr = fr_ + ov, fq = fq_ + ov;
        const int z = opaque0(); const int gs = gs0 + z; unsigned char* ws = a.ws + z; float* SSQ = (float*)(ws + WS_SSQ);
        const int li = gs >= 15 ? 1 : 0, st = gs - 2 - 13 * li;
        if (u.kind == 1) { EpiPlain e{(bf16*)(ws + WS_WQK + (size_t)li * 8 * SZ_DD), (unsigned)D}; e(acc, u, wr, wc, fr, fq); }
        else if (u.kind == 2) { EpiPlain e{(bf16*)(ws + WS_VWT + (size_t)li * 8 * SZ_DD), (unsigned)(8 * D)}; e(acc, u, wr, wc, fr, fq); }
        else if ((st == 0 || st == 11) && u.col0 >= 8192) { const int l = st == 11; Unit v = u; v.col0 = u.col0 - 8192; const size_t lo = (size_t)l * MEMR * D;
            EpiKV e{a.out + OUT_MK + lo, a.out + OUT_MV + lo, (bf16*)(ws + WS_MEMK) + lo, (bf16*)(ws + WS_VT) + lo, (const float*)(ws + WS_MSSQ)}; e(acc, v, wr, wc, fr, fq); }
        else if (st == 0 || st == 11) { EpiGU e{(bf16*)(ws + WS_H), SSQ + (size_t)(li * 4 + (st == 11 ? 3 : 0)) * MPAD}; e(acc, u, wr, wc, fr, fq); }
        else if (st == 1 || st == 12 || st == 6 || st == 8) { const int so = li * 4 + (st == 1 ? 1 : st == 6 ? 2 : st == 8 ? 3 : 4);
            EpiRes e{gs == 3 ? INP(0) : (const float*)nullptr, (bf16*)(ws + WS_XB), SSQ + (size_t)so * MPAD, (st == 1 || st == 12) ? 0.5f : 1.f}; e(acc, u, wr, wc, fr, fq); }
        else if (st == 2) {
            if (li == 0) { EpiConvIn e{(bf16*)(ws + WS_M1), (bf16*)(ws + WS_M2), SSQ + (size_t)1 * MPAD, a.out + OUT_CP, a.out + OUT_CS}; e(acc, u, wr, wc, fr, fq); }
            else { EpiRecIn e{(bf16*)(ws + WS_M1), (_Float16*)(ws + WS_LOGF), (bf16*)(ws + WS_M2), (bf16*)(ws + WS_RG), SSQ + (size_t)5 * MPAD, INP(15)}; e(acc, u, wr, wc, fr, fq); } }
        else { EpiSoftmax e{(bf16*)(ws + WS_P), scr, SSQ + (size_t)(li * 4 + 2) * MPAD}; e(acc, u, wr, wc, fr, fq); }
    }
};
}
template <int NG, int MTN> __device__ __forceinline__ void skinny_acc(const bf16* Ap, const bf16* B0, const bf16* B1, int lda, int nks, f32x4 (&acc0)[8], f32x4 (&acc1)[8]) {
    constexpr int BT = (NG == 2 ? 2 : 4) * (MTN <= 4 ? 2 : 1);
#pragma unroll 1
    for (int k4 = 0; k4 < nks; k4 += BT) {
        bf16x8 b0[BT], b1[BT], av[BT][MTN];
#pragma unroll
        for (int s = 0; s < BT; ++s) { const int ks = (k4 + s < nks) ? k4 + s : nks - 1;
            b0[s] = *(const bf16x8*)(B0 + 32 * ks); if (NG == 2) b1[s] = *(const bf16x8*)(B1 + 32 * ks);
#pragma unroll
            for (int i = 0; i < MTN; ++i) av[s][i] = *(const bf16x8*)(Ap + (size_t)(16 * i) * lda + 32 * ks); }
#pragma unroll
        for (int s = 0; s < BT; ++s) if (k4 + s < nks) {
#pragma unroll
            for (int i = 0; i < MTN; ++i) { acc0[i] = mfma16(b0[s], av[s][i], acc0[i]); if (NG == 2) acc1[i] = mfma16(b1[s], av[s][i], acc1[i]); } }
    }
}
__device__ __forceinline__ void skinny_phase(LAS unsigned char* lds, const Args& a, int gs0, int G, int bx) {
    const int z = opaque0(); const int gs = gs0 + z; GemmDesc d; gemm_desc(a, gs, true, d);
    unsigned char* ws = a.ws + z; float* SSQ = (float*)(ws + WS_SSQ);
    const int li = gs >= 15 ? 1 : 0, st = gs - 2 - 13 * li;
    const int tid = otid(), lane = tid & 63, w = __builtin_amdgcn_readfirstlane(tid >> 6), r = lane & 15, q = lane >> 4;
    const bool conv = (st == 2 && li == 0);
    const int ngrp = conv ? 64 + 64 : d.N / 16;
    const int RS = ngrp <= 64 ? 4 : (ngrp <= 128 ? 2 : 1), mtn = 8 / RS, nunits = ngrp * RS;
    const int kw = d.K / 8, nks = kw / 32;
    LAS f32x4* R = (LAS f32x4*)lds;
    const int mt_e = tid >> 6;
    const int ssq_in = li * 4 + (st == 2 ? 1 : st == 7 ? 2 : 3);
#pragma unroll 1
    for (int uu = bx; uu < nunits; uu += G) {
        const int u = uu / RS, rq = uu % RS, rbase = rq * 16 * mtn;
        const int row_s = rbase + 16 * mt_e + r, grow = MP + row_s;
        const float rs = pg8::ssq_rstd(SSQ + (size_t)ssq_in * MPAD, grow);
        const bool pair = conv && u >= 64;
        int n0, n1;
        if (pair) { const int j = u - 64; n0 = D + (j >> 3) * 256 + (j & 7) * 16; n1 = n0 + 128; }
        else { n0 = 16 * u; n1 = n0; }
        f32x4 acc0[8], acc1[8];
#pragma unroll
        for (int i = 0; i < 8; ++i) { acc0[i] = (f32x4){0.f, 0.f, 0.f, 0.f}; acc1[i] = (f32x4){0.f, 0.f, 0.f, 0.f}; }
        const bf16* Ap = (const bf16*)d.A + (size_t)(MP + rbase + r) * d.lda + w * kw + 8 * q;
        const bf16* B0 = (const bf16*)d.B + (size_t)(n0 + r) * d.ldb + w * kw + 8 * q;
        const bf16* B1 = (const bf16*)d.B + (size_t)(n1 + r) * d.ldb + w * kw + 8 * q;
        if (RS == 4) skinny_acc<1, 2>(Ap, B0, B1, d.lda, nks, acc0, acc1);
        else if (RS == 2) { if (pair) skinny_acc<2, 4>(Ap, B0, B1, d.lda, nks, acc0, acc1); else skinny_acc<1, 4>(Ap, B0, B1, d.lda, nks, acc0, acc1); }
        else skinny_acc<1, 8>(Ap, B0, B1, d.lda, nks, acc0, acc1);
#pragma unroll
        for (int i = 0; i < 8; ++i) if (i < mtn) { R[(w * 8 + i) * 64 + lane] = acc0[i]; if (pair) R[4096 + (w * 8 + i) * 64 + lane] = acc1[i]; }
        __syncthreads();
        if (mt_e < mtn) {
        f32x4 v0 = R[mt_e * 64 + lane], v1 = (f32x4){0.f, 0.f, 0.f, 0.f};
#pragma unroll
        for (int k = 1; k < 8; ++k) v0 += R[(k * 8 + mt_e) * 64 + lane];
        if (pair) {
#pragma unroll
            for (int k = 0; k < 8; ++k) v1 += R[4096 + (k * 8 + mt_e) * 64 + lane]; }
        const unsigned c0 = n0 + 4 * q;
        if (st == 1 || st == 12 || st == 6 || st == 10) {
            const int so = li * 4 + (st == 1 ? 1 : st == 6 ? 2 : st == 10 ? 3 : 4); const float alpha = (st == 1 || st == 12) ? 0.5f : 1.f;
            bf16* XB = (bf16*)(ws + WS_XB); f32x4 xi;
            if (gs == 3) xi = *(const f32x4*)(INP(1) + (size_t)row_s * D + c0);
            else { const u32x2 xw = *(const u32x2*)(XB + (size_t)grow * D + c0); xi = (f32x4){bflo(xw.x), bfhi(xw.x), bflo(xw.y), bfhi(xw.y)}; }
            const f32x4 x0 = xi + v0 * alpha;
            *(u32x2*)(XB + (size_t)grow * D + c0) = pg8::pk4(x0);
            float ss = (x0[0] * x0[0] + x0[1] * x0[1]) + (x0[2] * x0[2] + x0[3] * x0[3]);
            ss += __shfl_xor(ss, 16); ss += __shfl_xor(ss, 32);
            if (q == 0) pg8::ssq_add(SSQ + (size_t)so * MPAD, grow, ss);
        } else if (conv) {
            if (!pair) { *(u32x2*)((bf16*)(ws + WS_M1) + (size_t)grow * D + c0) = pg8::pk4(v0 * rs); }
            else { const unsigned ch = (u - 64) * 16 + 4 * q; const f32x4 v = (v0 * rs) * (v1 * rs);
                *(u32x2*)((bf16*)(ws + WS_M2) + (size_t)grow * D + ch) = pg8::pk4(v); *(f32x4*)(a.out + OUT_CS + ((size_t)row_s * 2 + 1) * D + ch) = v; }
        } else if (st == 2) {
            const int part = n0 >> 10; const unsigned ch0 = (n0 & 1023) + 4 * q;
            f32x4 y0 = v0 * rs;
            if (part == 1) { const float* lbr = INP(15); f32x4 o0;
#pragma unroll
                for (int e = 0; e < 4; ++e) { const float lb0 = __builtin_amdgcn_rcpf(1.f + __expf(lbr[ch0 + e] - lbr[D + ch0 + e]));
                    o0[e] = lb0 + (1.f - lb0) * __builtin_amdgcn_rcpf(1.f + __expf(-y0[e])); }
                *(f16x4*)((_Float16*)(ws + WS_LOGF) + (size_t)grow * D + ch0) = __builtin_convertvector(o0, f16x4);
            } else { if (part != 2) {
#pragma unroll
                    for (int e = 0; e < 4; ++e) y0[e] = silu_f(y0[e]); }
                bf16* dst = (bf16*)(ws + (part == 0 ? WS_M1 : part == 2 ? WS_M2 : WS_RG));
                *(u32x2*)(dst + (size_t)grow * D + ch0) = pg8::pk4(y0); }
        } else {
            *(u32x2*)((bf16*)(ws + WS_Q) + (size_t)grow * D + c0) = pg8::pk4(v0 * (rs * QSCALE));
        }
        }
        __syncthreads();
    }
}

__global__ void __launch_bounds__(NTHR, 2) mega_fwd(Args a) {
    extern __shared__ __attribute__((aligned(16))) unsigned char lds_raw[];
    LAS unsigned char* lds = (LAS unsigned char*)lds_raw;
    const int tid = otid(), G = gridDim.x, bx = blockIdx.x;
    const int vcu = (G % 8 == 0) ? (bx % 8) * (G / 8) + bx / 8 : bx;
    volatile LAS unsigned* misc = (volatile LAS unsigned*)(lds + LDS_MISC);
    if (tid < 64) misc[tid] = 0u;
    __syncthreads();
    XcdBarrier bar = xcd_barrier_post((unsigned*)(a.ws + WS_CTL) + 1024, misc + 8);
    const int lo = a.ph_lo, hi = a.ph_hi;
#pragma unroll 1
    for (int gs = lo; gs < hi; ++gs) {
        const int z = opaque0(); unsigned char* ws = a.ws + z;
        const int li = gs >= 15 ? 1 : 0, st = gs - 2 - 13 * li;
        const bool layer_step = gs >= 2 && gs < 28;
        if (gs == 1 || (layer_step && ((li == 0 && (st == 4 || st == 5)) || st == 9))) continue;
        const int nrep = (gs == REP_GS) ? 1 + REP_N : 1;
#define PART(p) (rep == 0 || (REP_PARTS & (p)))
#pragma unroll 1
        for (int rep = 0; rep < nrep; ++rep) {
        if (gs == 0) { if (DM(0)) prologue(a, z, lds, vcu, G);
        } else if (gs == 28) {
            if (DM(13)) {
            const float* ssq = (const float*)(ws + WS_SSQ) + (size_t)8 * MPAD; const float* gf = INP(28); const bf16* XBf = (const bf16*)(ws + WS_XB);
            const int nth = G * NTHR, gt = vcu * NTHR + otid();
            if ((nth & 127) == 0) {
                const int c4 = (gt & 127) * 8; const f32x4 g0 = *(const f32x4*)(gf + c4), g1 = *(const f32x4*)(gf + c4 + 4);
#pragma unroll 1
                for (int it0 = gt; it0 < MT * 128; it0 += 4 * nth) { u32x4 xw[4]; float r[4];
#pragma unroll
                    for (int j = 0; j < 4; ++j) { const int it = it0 + j * nth; const int row = it < MT * 128 ? (it >> 7) : 0; xw[j] = *(const u32x4*)(XBf + (size_t)row * D + c4); r[j] = pg8::ssq_rstd(ssq, row); }
#pragma unroll
                    for (int j = 0; j < 4; ++j) { const int it = it0 + j * nth; if (it < MT * 128) { const int row = it >> 7;
                        const f32x4 v0 = (f32x4){bflo(xw[j].x), bfhi(xw[j].x), bflo(xw[j].y), bfhi(xw[j].y)} * r[j] * g0, v1 = (f32x4){bflo(xw[j].z), bfhi(xw[j].z), bflo(xw[j].w), bfhi(xw[j].w)} * r[j] * g1;
                        float* dst = row < MP ? a.out + OUT_YP + (size_t)row * D + c4 : a.out + OUT_YS + (size_t)(row - MP) * D + c4;
                        *(f32x4*)dst = v0; *((f32x4*)dst + 1) = v1; } } }
            } else {
            for (int it = gt; it < MT * 128; it += nth) { const int row = it >> 7, c4 = (it & 127) * 8;
                const float r = pg8::ssq_rstd(ssq, row); const u32x4 xw = *(const u32x4*)(XBf + (size_t)row * D + c4);
                const f32x4 v0 = (f32x4){bflo(xw.x), bfhi(xw.x), bflo(xw.y), bfhi(xw.y)} * r * *(const f32x4*)(gf + c4), v1 = (f32x4){bflo(xw.z), bfhi(xw.z), bflo(xw.w), bfhi(xw.w)} * r * *(const f32x4*)(gf + c4 + 4);
                float* dst = row < MP ? a.out + OUT_YP + (size_t)row * D + c4 : a.out + OUT_YS + (size_t)(row - MP) * D + c4;
                *(f32x4*)dst = v0; *((f32x4*)dst + 1) = v1; } } }
        } else if (layer_step && st == 3) {
            if (li == 0) { if (DM(6)) conv_phase(a, z, vcu, G); }
            else if (DM(7)) {
                   gla_g1_phase(lds, ws, bx, G);
#pragma unroll 1
                   for (int u = bx; u < NS * 8; u += G) sample_rec_unit(lds, a, z, u >> 3, u & 7); }
        } else if (layer_step && st == 4) { if (DM(8)) gla_g2(a, z, vcu, G);
        } else if (layer_step && st == 5) { if (DM(9)) {
            gla_g3_phase(lds, a, z, bx, G); }
        } else {
            if (DM(1) && PART(1) && st != 10) { GemmDesc d; gemm_desc(a, gs + z, false, d);
                pg8::SchedAny S{a, gs, G, bx}; pg8::EpiAny E{a, gs, (LAS float*)(lds + LDS_SCR)};
                pg8::gemm_phase(lds, d.K, d.lda, d.ldb, S, E); }
            if (layer_step && st != 8 && st != 0 && st != 11 && DM(14) && PART(2)) { __syncthreads(); skinny_phase(lds, a, gs, G, (bx + 128) % G); }
            if (st == 8 && DM(11) && PART(4)) {
                __syncthreads();
#pragma unroll 1
                for (int u = bx; u < NS * 2; u += G) sample_attn_unit(lds, INP(5) + (size_t)li * NS * NMEM * D, INP(6) + (size_t)li * NS * NMEM * D, (const bf16*)(ws + WS_Q), (bf16*)(ws + WS_O), u >> 1, u & 1);
            }
        }
        if (rep + 1 < nrep) xcd_barrier(bar);
        }
        if (gs + 1 < hi) { if (hi > 4096) cg::this_grid().sync();   xcd_barrier(bar); }
    }
}

extern "C" void kernel_launch(void* const* d_in, const int* in_sizes, int n_in, void* d_out, int out_size, void* d_ws, size_t ws_size, hipStream_t stream) {
    static int grid = 0;
    if (grid == 0) {
        if (n_in != 29 || ws_size < WS_END) { fprintf(stderr, "kernel_launch: unexpected n_in %d / ws %zu (need %zu)\n", n_in, ws_size, (size_t)WS_END); grid = -1; return; }
        int dev = 0, cus = 0, per_cu = 0;
        hipGetDevice(&dev); hipDeviceGetAttribute(&cus, hipDeviceAttributeMultiprocessorCount, dev);
        if (hipFuncSetAttribute((const void*)mega_fwd, hipFuncAttributeMaxDynamicSharedMemorySize, LDS_BYTES) != hipSuccess) { fprintf(stderr, "kernel_launch: hipFuncSetAttribute failed\n"); grid = -1; return; }
        hipOccupancyMaxActiveBlocksPerMultiprocessor(&per_cu, (const void*)mega_fwd, NTHR, LDS_BYTES);
        (void)hipGetLastError();
        if (per_cu < 1) fprintf(stderr, "kernel_launch: occupancy query says %d\n", per_cu);
        grid = cus;
    }
    if (grid < 0) return;
    hipMemsetAsync((char*)d_ws + WS_CTL, 0, CTL_BYTES, stream);
    Args a{};
    for (int i = 0; i < 29; ++i) a.in[i] = (const float*)d_in[i];
    a.out = (float*)d_out; a.ws = (unsigned char*)d_ws; a.ph_lo = 0; a.ph_hi = NSTEPS;
    void* args[] = {&a};
    hipError_t e = hipLaunchCooperativeKernel((const void*)mega_fwd, dim3(grid), dim3(NTHR), args, LDS_BYTES, stream);
    if (e != hipSuccess) fprintf(stderr, "cooperative launch failed: %s (grid %d)\n", hipGetErrorString(e), grid);
}
```

```cpp
#include <hip/hip_runtime.h>
#include <hip/hip_cooperative_groups.h>
#include <cstdio>
#include <cstdint>
namespace cg = cooperative_groups;

#ifndef DBG_MASK
#define DBG_MASK 0xFFFFF
#endif
#define DM(b) ((DBG_MASK >> (b)) & 1)
#ifndef REP_GS
#define REP_GS -1
#endif
#ifndef REP_N
#define REP_N 0
#endif
#ifndef REP_PARTS
#define REP_PARTS 7
#endif
#define LAS __attribute__((address_space(3)))
typedef unsigned short bf16;
typedef short bf16x8 __attribute__((ext_vector_type(8)));
typedef float f32x4 __attribute__((ext_vector_type(4)));
typedef float f32x2 __attribute__((ext_vector_type(2)));
typedef unsigned u32x4 __attribute__((ext_vector_type(4)));
typedef unsigned u32x2 __attribute__((ext_vector_type(2)));

constexpr int D = 1024, NB = 8, T = 2048, MP = NB * T, NS = 128, MT = MP + NS, MPAD = 16640, FF = 2816;
constexpr int NMEM = 256, MEMR = NB * NMEM;
constexpr float EPS = 1e-6f;
constexpr float QSCALE = 0.0625f * 1.4426950408889634f;
constexpr int NTHR = 512, NWAVES = 8;

constexpr size_t al256(size_t x) { return (x + 255) & ~(size_t)255; }
constexpr size_t WS_CTL = 0, CTL_BYTES = 65536;
constexpr size_t WS_SSQ = CTL_BYTES;
constexpr size_t WS_MSSQ = WS_SSQ + al256((size_t)9 * MPAD * 4);
constexpr size_t WS_WGU = WS_MSSQ + al256(MEMR * 4);
constexpr size_t SZ_WGU = (size_t)2 * FF * D * 2;
constexpr size_t WS_WD = WS_WGU + 4 * SZ_WGU;
constexpr size_t SZ_WD = (size_t)D * FF * 2;
constexpr size_t WS_WQ = WS_WD + 4 * SZ_WD;
constexpr size_t SZ_DD = (size_t)D * D * 2;
constexpr size_t WS_WKV = WS_WQ + 2 * SZ_DD;
constexpr size_t WS_WO = WS_WKV + 4 * SZ_DD;
constexpr size_t WS_WMO = WS_WO + 2 * SZ_DD;
constexpr size_t WS_WCI = WS_WMO + 2 * SZ_DD;
constexpr size_t WS_WRI = WS_WCI + 3 * SZ_DD;
constexpr size_t WS_X = WS_WRI + 4 * SZ_DD;
constexpr size_t SZ_ACT2 = (size_t)MPAD * D * 2, SZ_ACT4 = (size_t)MPAD * D * 4;
constexpr size_t WS_XB = WS_X + SZ_ACT4;
constexpr size_t WS_H = WS_XB + SZ_ACT2;
constexpr size_t WS_MEMB = WS_H + (size_t)MPAD * FF * 2;
constexpr size_t WS_MEMK = WS_MEMB + (size_t)MEMR * D * 2;
constexpr size_t WS_VT = WS_MEMK + 2 * (size_t)MEMR * D * 2;
constexpr size_t WS_Q = WS_VT + 2 * (size_t)MEMR * D * 2;
constexpr size_t WS_P = WS_Q + SZ_ACT2;
constexpr size_t WS_O = WS_P + SZ_ACT2;
constexpr size_t WS_M1 = WS_O + SZ_ACT2;
constexpr size_t WS_M2 = WS_M1 + SZ_ACT2;
constexpr size_t WS_RG = WS_M2 + SZ_ACT2;
constexpr size_t WS_LOGF = WS_RG + SZ_ACT2;
constexpr size_t WS_G = WS_LOGF + SZ_ACT4;
constexpr size_t WS_QBG = WS_G + SZ_ACT2;
constexpr size_t WS_OINTRA = WS_QBG + (size_t)MP * D * 2;
constexpr size_t WS_UT = WS_OINTRA + (size_t)MP * D * 4;
constexpr size_t WS_SPT = WS_UT + (size_t)2048 * 16384 * 4;
constexpr size_t WS_DEC = WS_SPT + (size_t)2048 * 16384 * 2;
constexpr size_t WS_WQN = WS_DEC + (size_t)2048 * 128 * 4;
constexpr size_t WS_WQK = WS_WQN + 2 * SZ_DD;
constexpr size_t WS_VWT = WS_WQK + 2 * 8 * SZ_DD;
constexpr size_t WS_END = WS_VWT + 2 * 8 * SZ_DD;
static_assert(WS_END <= (size_t)1023 * 1024 * 1024, "workspace map too large");

constexpr size_t OUT_YP = 0, OUT_YS = (size_t)MP * D, OUT_MK = OUT_YS + (size_t)NS * D, OUT_MV = OUT_MK + (size_t)2 * MEMR * D,
                 OUT_CP = OUT_MV + (size_t)2 * MEMR * D, OUT_RP = OUT_CP + (size_t)NB * 2 * D, OUT_CS = OUT_RP + (size_t)NB * 8 * 16384,
                 OUT_RS = OUT_CS + (size_t)NS * 2 * D;

constexpr int LDS_STAGE = 131072, LDS_SCR = 131072, LDS_MISC = LDS_SCR + 12288, LDS_BYTES = 147456;

__device__ __forceinline__ unsigned f2bf(float f) { unsigned u = __builtin_bit_cast(unsigned, f); return (u + 0x7fffu + ((u >> 16) & 1u)) >> 16; }
typedef __bf16 bf16x2_t __attribute__((ext_vector_type(2)));
typedef _Float16 f16x4 __attribute__((ext_vector_type(4)));
__device__ __forceinline__ unsigned pk2(float lo, float hi) { const f32x2 v = {lo, hi}; const bf16x2_t b = __builtin_convertvector(v, bf16x2_t); return __builtin_bit_cast(unsigned, b); }
__device__ __forceinline__ float bf2f(unsigned b) { return __builtin_bit_cast(float, b << 16); }
__device__ __forceinline__ float bflo(unsigned w) { return __builtin_bit_cast(float, w << 16); }
__device__ __forceinline__ float bfhi(unsigned w) { return __builtin_bit_cast(float, w & 0xffff0000u); }
__device__ __forceinline__ float wave_sum(float v) {
#pragma unroll
    for (int o = 1; o < 64; o <<= 1) v += __shfl_xor(v, o);
    return v;
}
__device__ __forceinline__ float wave_max(float v) {
#pragma unroll
    for (int o = 1; o < 64; o <<= 1) v = fmaxf(v, __shfl_xor(v, o));
    return v;
}
__device__ __forceinline__ int otid() { int t; asm volatile("v_mov_b32 %0, %1" : "=v"(t) : "v"((int)threadIdx.x)); return t; }
__device__ __forceinline__ float silu_f(float g) { return g * __builtin_amdgcn_rcpf(1.f + __expf(-g)); }
#define LDS_WAIT() asm volatile("s_waitcnt lgkmcnt(0)" ::: "memory")

#define XB_TMO      128
#define XB_XCNT(j)  (256  + 64 * (j))
#define XB_XSUB(j)  (1280 + 64 * (j))
#define XB_XGEN(j)  (2304 + 64 * (j))
#define XB_TOP      3328
#define XB_TOPGEN   3392
#define XCD_BAR_WORDS 3456
#define XB_SPIN_CAP (1u << 22)
__device__ __forceinline__ unsigned xb_ld(unsigned* p)              { return __hip_atomic_load(p, __ATOMIC_RELAXED, __HIP_MEMORY_SCOPE_AGENT); }
__device__ __forceinline__ unsigned xb_add(unsigned* p, unsigned v) { return __hip_atomic_fetch_add(p, v, __ATOMIC_RELAXED, __HIP_MEMORY_SCOPE_AGENT); }
__device__ __forceinline__ unsigned xb_xcc_id() { return (unsigned)__builtin_amdgcn_s_getreg((3 << 11) | 20) & 0xFu; }
#define XB_SPIN(cond, bar) do { unsigned _sp = 0; while (cond) { __builtin_amdgcn_s_sleep(1); \
    if ((++_sp & 255u) == 0u) { if (xb_ld(&(bar)[XB_TMO])) break; if (_sp > XB_SPIN_CAP) { atomicAdd(&(bar)[XB_TMO], 1u); break; } } } } while (0)
struct XcdBarrier { unsigned* bar; unsigned x; volatile LAS unsigned* st; };
__device__ __forceinline__ XcdBarrier xcd_barrier_post(unsigned* bar, volatile LAS unsigned* st) {
    XcdBarrier b; b.bar = bar; b.x = xb_xcc_id(); b.st = st;
    if (threadIdx.x == 0) (void)xb_add(&bar[XB_XCNT(b.x)], 1u);
    return b;
}
__device__ __forceinline__ void xcd_barrier_complete(unsigned* bar, unsigned x, unsigned& nloc, unsigned& nx) {
    const unsigned G = gridDim.x * gridDim.y * gridDim.z;
    unsigned sum, cnt, mine, sp = 0u;
    for (;;) {
        sum = 0u; cnt = 0u; mine = 0u;
#pragma unroll
        for (unsigned j = 0; j < 16; ++j) { const unsigned c = xb_ld(&bar[XB_XCNT(j)]); sum += c; cnt += (c > 0u) ? 1u : 0u; mine = (j == x) ? c : mine; }
        if (sum == G) break;
        __builtin_amdgcn_s_sleep(1);
        if ((++sp & 255u) == 0u) { if (xb_ld(&bar[XB_TMO])) break; if (sp > XB_SPIN_CAP) { atomicAdd(&bar[XB_TMO], 1u); break; } }
    }
    nloc = mine > 0u ? mine : 1u; nx = cnt > 0u ? cnt : 1u;
}
__device__ __forceinline__ void xcd_barrier(const XcdBarrier& b) {
    asm volatile("s_waitcnt vmcnt(0)" ::: "memory");
    __syncthreads();
    if (threadIdx.x == 0) {
        unsigned* bar = b.bar;
        __builtin_amdgcn_s_waitcnt(0);
        unsigned nloc = b.st[0], nx = b.st[1];
        if (nloc == 0u) { xcd_barrier_complete(bar, b.x, nloc, nx); b.st[0] = nloc; b.st[1] = nx; }
        const unsigned old = xb_add(&bar[XB_XSUB(b.x)], 1u);
        const unsigned gen = old / nloc;
        if (old + 1u == (gen + 1u) * nloc) {
            __builtin_amdgcn_fence(__ATOMIC_RELEASE, "agent");
            asm volatile("s_waitcnt vmcnt(0)" ::: "memory");
            const unsigned og = xb_add(&bar[XB_TOP], 1u);
            const unsigned tg = og / nx;
            if (og + 1u == (tg + 1u) * nx) xb_add(&bar[XB_TOPGEN], 1u);
            else XB_SPIN(xb_ld(&bar[XB_TOPGEN]) == tg, bar);
            __builtin_amdgcn_fence(__ATOMIC_ACQUIRE, "agent");
            xb_add(&bar[XB_XGEN(b.x)], 1u);
            asm volatile("s_waitcnt vmcnt(0)" ::: "memory");
        } else {
            XB_SPIN(xb_ld(&bar[XB_XGEN(b.x)]) == gen, bar);
            __builtin_amdgcn_fence(__ATOMIC_ACQUIRE, "agent");
            asm volatile("s_waitcnt vmcnt(0)" ::: "memory");
        }
    }
    __syncthreads();
}

namespace pg8 {
constexpr int BM = 256, BK = 64, HALF = 128, HTB = HALF * BK * 2, STAGE_BYTES = 8 * HTB, NXCD = 8, WGM = 8;
__device__ __forceinline__ int lds_byte(int r, int c) { const int st = (r >> 4) * 2 + (c >> 5), rr = r & 15, cc = c & 31, ob = rr * 64 + cc * 2; return st * 1024 + (ob ^ (((ob >> 9) & 1) << 5)); }
__device__ __forceinline__ void stage_rc(int b, int& R, int& C) { const int st = b / 1024, sb = b % 1024, swz = sb ^ (((sb >> 9) & 1) << 5); R = (st >> 1) * 16 + swz / 64; C = (st & 1) * 32 + (swz % 64) / 2; }

struct Unit { const char* A; const char* B; int row0, col0, nt, kind; };

typedef f32x4 Acc[2][2][4][2];

template <class Epi, class Sched>
__device__ __forceinline__ void gemm_phase(LAS unsigned char* lds, int K, int lda, int ldb, const Sched& S, const Epi& E) {
    const int tid = otid(), wid = __builtin_amdgcn_readfirstlane(tid >> 6), lane = tid & 63, wr = wid >> 2, wc = wid & 3, fr = lane & 15, fq = lane >> 4;
    unsigned voffA[2], voffB[2];
#pragma unroll
    for (int i = 0; i < 2; ++i) { int R, C; stage_rc(tid * 16 + i * 8192, R, C); const int rho = R & 31, Rb = (R & ~31) + 8 * ((rho & 15) >> 2) + 4 * (rho >> 4) + (rho & 3);
        voffA[i] = (unsigned)(R * lda + C) * 2u; voffB[i] = (unsigned)(Rb * ldb + C) * 2u; }
    const size_t kstep = (size_t)(BK * 2);
    const size_t hstepA = (size_t)HALF * lda * 2, hstepB = (size_t)HALF * ldb * 2;
    const unsigned ldsw = (unsigned)wid * 1024u;
    const int aoff = lds_byte(wr * 64 + fr, fq * 8), boff = lds_byte(wc * 32 + fr, fq * 8);
#define PG8_SA(b, h) (((b) * 2 + (h)) * HTB)
#define PG8_SB(b, h) ((4 + (b) * 2 + (h)) * HTB)
#define PG8_STAGE(bufoff, gbase, voff) do { _Pragma("unroll") for (int _i = 0; _i < 2; ++_i) \
        __builtin_amdgcn_global_load_lds((const unsigned*)((const char*)(gbase) + (voff)[_i]), (LAS unsigned*)(lds + (bufoff) + ldsw + _i * 8192), 16, 0, 0); } while (0)
#define PG8_LDA(dst, b, h) do { _Pragma("unroll") for (int m = 0; m < 4; ++m) _Pragma("unroll") for (int k = 0; k < 2; ++k) dst[m][k] = *(const LAS bf16x8*)(lds + PG8_SA(b, h) + aoff + m * 2048 + k * 1024); } while (0)
#define PG8_LDB(dst, b, h) do { _Pragma("unroll") for (int n = 0; n < 2; ++n) _Pragma("unroll") for (int k = 0; k < 2; ++k) dst[n][k] = *(const LAS bf16x8*)(lds + PG8_SB(b, h) + boff + n * 2048 + k * 1024); } while (0)
#define PG8_MMA(ai, bj, At, Bt) do { __builtin_amdgcn_s_setprio(1); _Pragma("unroll") for (int m = 0; m < 4; ++m) _Pragma("unroll") for (int n = 0; n < 2; ++n) _Pragma("unroll") for (int k = 0; k < 2; ++k) \
        acc[ai][bj][m][n] = __builtin_amdgcn_mfma_f32_16x16x32_bf16(Bt[n][k], At[m][k], acc[ai][bj][m][n], 0, 0, 0); __builtin_amdgcn_s_setprio(0); } while (0)
#define PG8_WAIT_V(n) asm volatile("s_waitcnt vmcnt(" #n ")" ::: "memory")
#define PG8_WAIT_L(n) asm volatile("s_waitcnt lgkmcnt(" #n ")" ::: "memory")
#define PG8_BAR __builtin_amdgcn_s_barrier()
#define PG8_SCHED __builtin_amdgcn_sched_barrier(0)
    Unit cur, nxt; int ui = 0;
    if (!S.next(0, cur)) return;
    Acc acc;
#pragma unroll
    for (int a = 0; a < 2; ++a)
#pragma unroll
        for (int b = 0; b < 2; ++b)
#pragma unroll
            for (int m = 0; m < 4; ++m)
#pragma unroll
                for (int n = 0; n < 2; ++n) acc[a][b][m][n] = (f32x4){0.f, 0.f, 0.f, 0.f};
    bf16x8 At[4][2], B0[2][2], B1[2][2];
    const char* cA = cur.A; const char* cB = cur.B;
    PG8_STAGE(PG8_SB(0, 0), cB, voffB); PG8_STAGE(PG8_SB(0, 1), cB + hstepB, voffB); PG8_STAGE(PG8_SA(0, 0), cA, voffA); PG8_STAGE(PG8_SA(0, 1), cA + hstepA, voffA);
    if (wr == 1) PG8_BAR;
    PG8_WAIT_V(2); PG8_BAR;
    PG8_STAGE(PG8_SB(1, 0), cB + kstep, voffB); PG8_STAGE(PG8_SA(1, 0), cA + kstep, voffA); PG8_STAGE(PG8_SB(1, 1), cB + hstepB + kstep, voffB);
    PG8_WAIT_V(6); PG8_BAR;
    for (;;) {
        const bool has_next = S.next(ui + 1, nxt);
        const char* nA = has_next ? nxt.A : cA; const char* nB = has_next ? nxt.B : cB;
#pragma unroll 1
        for (int t = 0; t < cur.nt; t += 2) {
            const bool last = (t == cur.nt - 2);
            const char* a1 = cA + (size_t)(t + 1) * kstep;
            const char* a2 = last ? nA : cA + (size_t)(t + 2) * kstep; const char* b2 = last ? nB : cB + (size_t)(t + 2) * kstep;
            const char* a3 = a2 + kstep; const char* b3 = b2 + kstep;
            PG8_LDB(B0, 0, 0); PG8_LDB(B1, 0, 1); PG8_SCHED; PG8_LDA(At, 0, 0); PG8_STAGE(PG8_SA(1, 1), a1 + hstepA, voffA);
            PG8_WAIT_V(8); PG8_WAIT_L(0); PG8_BAR; PG8_MMA(0, 0, At, B0); PG8_MMA(0, 1, At, B1); PG8_BAR; PG8_SCHED;
            PG8_LDA(At, 0, 1); PG8_STAGE(PG8_SB(0, 0), b2, voffB); PG8_STAGE(PG8_SB(0, 1), b2 + hstepB, voffB); PG8_STAGE(PG8_SA(0, 0), a2, voffA);
            PG8_WAIT_V(8); PG8_WAIT_L(0); PG8_BAR; PG8_MMA(1, 0, At, B0); PG8_MMA(1, 1, At, B1); PG8_BAR; PG8_SCHED;
            PG8_LDB(B0, 1, 0); PG8_LDB(B1, 1, 1); PG8_SCHED; PG8_LDA(At, 1, 0); PG8_STAGE(PG8_SA(0, 1), a2 + hstepA, voffA);
            PG8_WAIT_V(8); PG8_WAIT_L(0); PG8_BAR; PG8_MMA(0, 0, At, B0); PG8_MMA(0, 1, At, B1); PG8_BAR; PG8_SCHED;
            PG8_LDA(At, 1, 1); PG8_STAGE(PG8_SB(1, 0), b3, voffB); PG8_STAGE(PG8_SB(1, 1), b3 + hstepB, voffB); PG8_STAGE(PG8_SA(1, 0), a3, voffA);
            PG8_WAIT_V(8); PG8_WAIT_L(0); PG8_BAR; PG8_MMA(1, 0, At, B0); PG8_MMA(1, 1, At, B1); PG8_BAR; PG8_SCHED;
        }
        if (wr == 0) PG8_BAR;
        E(acc, cur, wr, wc, fr, fq);
        if (!has_next) break;
#pragma unroll
        for (int a = 0; a < 2; ++a)
#pragma unroll
            for (int b = 0; b < 2; ++b)
#pragma unroll
                for (int m = 0; m < 4; ++m)
#pragma unroll
                    for (int n = 0; n < 2; ++n) acc[a][b][m][n] = (f32x4){0.f, 0.f, 0.f, 0.f};
        cur = nxt; cA = nA; cB = nB; ++ui;
        if (wr == 1) PG8_BAR;
    }
    PG8_WAIT_V(0);
    PG8_BAR;
#undef PG8_SA
#undef PG8_SB
#undef PG8_STAGE
#undef PG8_LDA
#undef PG8_LDB
#undef PG8_MMA
}

struct Sched2D {
    const char* A; const char* B; int lda, ldb, nM, nN, nwg, G, c; size_t bstride;
    __device__ __forceinline__ void init(const bf16* A_, int lda_, const bf16* B_, int ldb_, int M, int N, int G_, int c_) {
        A = (const char*)A_; B = (const char*)B_; bstride = 0; lda = lda_; ldb = ldb_; nM = M / BM; nN = N / BM; nwg = nM * nN; G = G_; c = c_; }
    __device__ __forceinline__ bool next(int i, Unit& u) const {
        const long L = (long)i * G + c; if (L >= nwg) return false;
        int wgid = (int)L; { const int q = nwg / NXCD, r = nwg % NXCD, xcd = wgid % NXCD, off = wgid / NXCD; wgid = (xcd < r ? xcd * (q + 1) : r * (q + 1) + (xcd - r) * q) + off; }
        const int nig = WGM * nN, gid = wgid / nig, fm = gid * WGM, gsz = (nM - fm) < WGM ? (nM - fm) : WGM;
        const int pm = fm + ((wgid % nig) % gsz), pn = (wgid % nig) / gsz;
        u.A = A + (size_t)pm * BM * lda * 2; u.B = B + (size_t)(pm >> 3) * bstride + (size_t)pn * BM * ldb * 2; u.row0 = pm * BM; u.col0 = pn * BM; return true;
    }
};
struct SchedAttn {
    const char* A; const char* B; int mode, G, c;
    __device__ __forceinline__ bool next(int i, Unit& u) const {
        const int L = i * G + c; if (L >= 256) return false;
        const int wgid = (L % NXCD) * 32 + L / NXCD;
        const int bh = wgid >> 3, qt = wgid & 7, b = bh >> 2, h = bh & 3;
        u.row0 = b * T + qt * 256; u.col0 = h * 256;
        u.A = A + ((size_t)u.row0 * D + h * 256) * 2;
        u.B = mode == 0 ? B + ((size_t)(b * NMEM) * D + h * 256) * 2 : B + ((size_t)(h * 256) * MEMR + b * NMEM) * 2;
        return true;
    }
};

constexpr float SSQ_FX = 1024.f;
__device__ __forceinline__ float ssq_rstd(const float* ssq, unsigned row) { return rsqrtf((float)*(const unsigned*)((const char*)ssq + row * 4u) * (1.f / (SSQ_FX * D)) + EPS); }
__device__ __forceinline__ void ssq_add(float* ssq, unsigned row, float ss) { atomicAdd((unsigned*)ssq + row, (unsigned)(ss * SSQ_FX + 0.5f)); }
#define EPI_ARGS const Acc& acc, const Unit& u, int wr, int wc, int fr, int fq
#define FOR_AM _Pragma("unroll") for (int ai = 0; ai < 2; ++ai) _Pragma("unroll") for (int m = 0; m < 4; ++m)
#define FOR_BN _Pragma("unroll") for (int bj = 0; bj < 2; ++bj) _Pragma("unroll") for (int n = 0; n < 2; ++n)
#define LOAD_RSTD(rr, ssqp, rbase) float rr[2][4]; FOR_AM rr[ai][m] = ssq_rstd(ssqp, (rbase) + ai * 128 + m * 16)
#define EPI_FENCE() do { asm volatile("" ::: "memory"); __builtin_amdgcn_sched_barrier(0); } while (0)
template <class Tp> __device__ __forceinline__ Tp& at(void* base, unsigned byteoff) { return *(Tp*)((char*)base + byteoff); }
template <class Tp> __device__ __forceinline__ const Tp& atc(const void* base, unsigned byteoff) { return *(const Tp*)((const char*)base + byteoff); }
__device__ __forceinline__ u32x2 pk4(const f32x4 v) { u32x2 w; w.x = pk2(v[0], v[1]); w.y = pk2(v[2], v[3]); return w; }
__device__ __forceinline__ u32x4 pk8(const f32x4 v0, const f32x4 v1) { u32x4 w; w.x = pk2(v0[0], v0[1]); w.y = pk2(v0[2], v0[3]); w.z = pk2(v1[0], v1[1]); w.w = pk2(v1[2], v1[3]); return w; }
#define FOR_BJ _Pragma("unroll") for (int bj = 0; bj < 2; ++bj)

struct EpiGU { bf16* H; const float* ssq;
    __device__ __forceinline__ void operator()(EPI_ARGS) const {
        const unsigned hcol = (u.col0 >> 1) + wc * 32 + 8 * fq; const unsigned rb = u.row0 + wr * 64 + fr;
        LOAD_RSTD(rr, ssq, rb);
        FOR_AM { const unsigned row = rb + ai * 128 + m * 16; const float r = rr[ai][m];
            f32x4 hv[2];
#pragma unroll
            for (int n = 0; n < 2; ++n) { const f32x4 g = acc[ai][0][m][n] * r, up = acc[ai][1][m][n] * r;
                const float d0 = 1.f + __expf(-fmaxf(g[0], -30.f)), d1 = 1.f + __expf(-fmaxf(g[1], -30.f)), d2 = 1.f + __expf(-fmaxf(g[2], -30.f)), d3 = 1.f + __expf(-fmaxf(g[3], -30.f));
                const float r01 = __builtin_amdgcn_rcpf(d0 * d1), r23 = __builtin_amdgcn_rcpf(d2 * d3);
                hv[n] = (f32x4){g[0] * up[0] * (r01 * d1), g[1] * up[1] * (r01 * d0), g[2] * up[2] * (r23 * d3), g[3] * up[3] * (r23 * d2)}; }
            at<u32x4>(H, (row * FF + hcol) * 2u) = pk8(hv[0], hv[1]);
            EPI_FENCE(); }
    }
};
struct EpiRes { const float* Xin; bf16* XB; float* ssq_out; float alpha;
    __device__ __forceinline__ void operator()(EPI_ARGS) const {
        const unsigned rb = u.row0 + wr * 64 + fr, cb = u.col0 + wc * 32 + 8 * fq;
#pragma unroll
        for (int ai = 0; ai < 2; ++ai) {
            u32x4 xpre[4][2];
            if (!Xin) {
#pragma unroll
                for (int m = 0; m < 4; ++m) { FOR_BJ { xpre[m][bj] = atc<u32x4>(XB, ((rb + ai * 128 + m * 16) * D + cb + bj * 128) * 2u); } } }
#pragma unroll
            for (int m = 0; m < 4; ++m) { const unsigned row = rb + ai * 128 + m * 16; float ss = 0.f;
                FOR_BJ { const unsigned off = row * D + cb + bj * 128; f32x4 x0, x1;
                    if (Xin) { x0 = atc<f32x4>(Xin, off * 4u); x1 = atc<f32x4>(Xin, off * 4u + 16u); }
                    else { const u32x4 xw = xpre[m][bj]; x0 = (f32x4){bflo(xw.x), bfhi(xw.x), bflo(xw.y), bfhi(xw.y)}; x1 = (f32x4){bflo(xw.z), bfhi(xw.z), bflo(xw.w), bfhi(xw.w)}; }
                    const f32x4 v0 = x0 + acc[ai][bj][m][0] * alpha, v1 = x1 + acc[ai][bj][m][1] * alpha;
                    ss += ((v0[0] * v0[0] + v0[1] * v0[1]) + (v0[2] * v0[2] + v0[3] * v0[3])) + ((v1[0] * v1[0] + v1[1] * v1[1]) + (v1[2] * v1[2] + v1[3] * v1[3]));
                    at<u32x4>(XB, off * 2u) = pk8(v0, v1); }
                ss += __shfl_xor(ss, 16); ss += __shfl_xor(ss, 32);
                if (fq == 0) ssq_add(ssq_out, row, ss);
                EPI_FENCE(); }
        }
    }
};
struct EpiConvIn { bf16* CB; bf16* CV; const float* ssq; float* out_cp; float* out_cs;
    __device__ __forceinline__ void operator()(EPI_ARGS) const {
        const int pn = u.col0 >> 8; const unsigned rb = u.row0 + wr * 64 + fr;
        LOAD_RSTD(rr, ssq, rb);
        if (pn < 4) {
            const unsigned cb = u.col0 + wc * 32 + 8 * fq;
            FOR_AM { const unsigned row = rb + ai * 128 + m * 16; const float r = rr[ai][m];
                FOR_BJ { at<u32x4>(CB, (row * D + cb + bj * 128) * 2u) = pk8(acc[ai][bj][m][0] * r, acc[ai][bj][m][1] * r); }
                EPI_FENCE(); }
        } else {
            const unsigned cb = (pn - 4) * 128 + wc * 32 + 8 * fq;
            FOR_AM { const unsigned row = rb + ai * 128 + m * 16; const float r = rr[ai][m];
#pragma unroll
                for (int n = 0; n < 2; ++n) { const unsigned ch = cb + n * 4; const f32x4 v = (acc[ai][0][m][n] * r) * (acc[ai][1][m][n] * r);
                    at<u32x2>(CV, (row * D + ch) * 2u) = pk4(v);
                    if (row < (unsigned)MP) { const unsigned t = row & (T - 1); if (t >= (unsigned)(T - 2)) at<f32x4>(out_cp, (((row >> 11) * 2 + (t - (T - 2))) * D + ch) * 4u) = v; }
                    else if (row < (unsigned)MT) at<f32x4>(out_cs, (((row - MP) * 2 + 1) * D + ch) * 4u) = v; }
                EPI_FENCE(); }
        }
    }
};
struct EpiRecIn { bf16* RQ; _Float16* LOGF; bf16* RI; bf16* RG; const float* ssq; const float* lb_raw;
    __device__ __forceinline__ void operator()(EPI_ARGS) const {
        const int pn = u.col0 >> 8, part = pn >> 2; const unsigned rb = u.row0 + wr * 64 + fr, cb = (pn & 3) * 256 + wc * 32 + 8 * fq;
        LOAD_RSTD(rr, ssq, rb);
        if (part == 1) {
            f32x4 lbv[2][2];
            FOR_BN { const unsigned ch = cb + bj * 128 + n * 4; const f32x4 l0 = atc<f32x4>(lb_raw, ch * 4u), l1 = atc<f32x4>(lb_raw, (D + ch) * 4u);
#pragma unroll
                for (int e = 0; e < 4; ++e) lbv[bj][n][e] = __builtin_amdgcn_rcpf(1.f + __expf(l0[e] - l1[e])); }
            FOR_AM { const unsigned row = rb + ai * 128 + m * 16; const float r = rr[ai][m];
                FOR_BN { const f32x4 v = acc[ai][bj][m][n] * r; f32x4 o;
#pragma unroll
                    for (int e = 0; e < 4; ++e) { const float lb = lbv[bj][n][e]; const float sg = __builtin_amdgcn_rcpf(1.f + __expf(-v[e])); o[e] = lb + (1.f - lb) * sg; }
                    at<f16x4>(LOGF, (row * D + cb + bj * 128 + n * 4) * 2u) = __builtin_convertvector(o, f16x4); }
                EPI_FENCE(); }
        } else if (part == 2) {
            FOR_AM { const unsigned row = rb + ai * 128 + m * 16; const float r = rr[ai][m];
                FOR_BJ { at<u32x4>(RI, (row * D + cb + bj * 128) * 2u) = pk8(acc[ai][bj][m][0] * r, acc[ai][bj][m][1] * r); }
                EPI_FENCE(); }
        } else {
            bf16* dst = part == 0 ? RQ : RG;
            FOR_AM { const unsigned row = rb + ai * 128 + m * 16; const float r = rr[ai][m];
                FOR_BJ { f32x4 v0 = acc[ai][bj][m][0] * r, v1 = acc[ai][bj][m][1] * r;
#pragma unroll
                    for (int e = 0; e < 4; ++e) { v0[e] = silu_f(v0[e]); v1[e] = silu_f(v1[e]); }
                    at<u32x4>(dst, (row * D + cb + bj * 128) * 2u) = pk8(v0, v1); }
                EPI_FENCE(); }
        }
    }
};
struct EpiQ { bf16* Q; const float* ssq; float scale;
    __device__ __forceinline__ void operator()(EPI_ARGS) const {
        const unsigned rb = u.row0 + wr * 64 + fr, cb = u.col0 + wc * 32 + 8 * fq;
        FOR_AM { const unsigned row = rb + ai * 128 + m * 16; const float r = ssq_rstd(ssq, row) * scale;
            FOR_BN { at<u32x2>(Q, (row * D + cb + bj * 128 + n * 4) * 2u) = pk4(acc[ai][bj][m][n] * r); }
            EPI_FENCE(); }
    }
};
struct EpiKV { float* outK; float* outV; bf16* MK; bf16* VT; const float* mssq;
    __device__ __forceinline__ void operator()(EPI_ARGS) const {
        const unsigned rb = u.row0 + wr * 64 + fr, cb = (u.col0 & (D - 1)) + wc * 32 + 8 * fq; const bool isK = u.col0 < D;
        float rr[2][4]; FOR_AM rr[ai][m] = rsqrtf(atc<float>(mssq, (rb + ai * 128 + m * 16) * 4u) * (1.f / D) + EPS);
        FOR_AM { const unsigned row = rb + ai * 128 + m * 16; const float r = rr[ai][m];
            FOR_BJ { const unsigned col = cb + bj * 128; const f32x4 v0 = acc[ai][bj][m][0] * r, v1 = acc[ai][bj][m][1] * r;
                float* of = isK ? outK : outV; bf16* ob = isK ? MK : VT;
                at<f32x4>(of, (row * D + col) * 4u) = v0; at<f32x4>(of, (row * D + col) * 4u + 16u) = v1; at<u32x4>(ob, (row * D + col) * 2u) = pk8(v0, v1); }
            EPI_FENCE(); }
    }
};
struct EpiSoftmax { bf16* P; LAS float* scr; const float* ssq;
    __device__ __forceinline__ void operator()(EPI_ARGS) const {
        LAS float* mx = scr; LAS float* sm = scr + 1024;
        const unsigned rl0 = wr * 64 + fr, cb = u.col0 + wc * 32 + 8 * fq;
        { LOAD_RSTD(s1, ssq, u.row0 + rl0);
        FOR_AM { const unsigned rl = rl0 + ai * 128 + m * 16; const float sc = s1[ai][m] * QSCALE; float v = -3.0e38f;
            FOR_BN { const f32x4 a = acc[ai][bj][m][n]; v = fmaxf(v, fmaxf(fmaxf(a[0], a[1]), fmaxf(a[2], a[3]))); }
            v *= sc;
            v = fmaxf(v, __shfl_xor(v, 16)); v = fmaxf(v, __shfl_xor(v, 32));
            if (fq == 0) mx[rl * 4 + wc] = v; } }
        LDS_WAIT(); __builtin_amdgcn_s_barrier(); asm volatile("" ::: "memory");
        { LOAD_RSTD(s2, ssq, u.row0 + rl0);
        FOR_AM { const unsigned rl = rl0 + ai * 128 + m * 16; const float sc = s2[ai][m] * QSCALE;
            const f32x4 q = *(LAS f32x4*)(mx + rl * 4); const float M = fmaxf(fmaxf(q[0], q[1]), fmaxf(q[2], q[3]));
            float s = 0.f;
            FOR_BN { const f32x4 a = acc[ai][bj][m][n] * sc; s += (__builtin_amdgcn_exp2f(a[0] - M) + __builtin_amdgcn_exp2f(a[1] - M)) + (__builtin_amdgcn_exp2f(a[2] - M) + __builtin_amdgcn_exp2f(a[3] - M)); }
            s += __shfl_xor(s, 16); s += __shfl_xor(s, 32);
            if (fq == 0) sm[rl * 4 + wc] = s; EPI_FENCE(); } }
        LDS_WAIT(); __builtin_amdgcn_s_barrier(); asm volatile("" ::: "memory");
        { LOAD_RSTD(s3, ssq, u.row0 + rl0);
        FOR_AM { const unsigned rl = rl0 + ai * 128 + m * 16; const float sc = s3[ai][m] * QSCALE;
            const f32x4 q = *(LAS f32x4*)(sm + rl * 4); const float inv = __builtin_amdgcn_rcpf((q[0] + q[1]) + (q[2] + q[3]));
            const f32x4 qm = *(LAS f32x4*)(mx + rl * 4); const float M = fmaxf(fmaxf(qm[0], qm[1]), fmaxf(qm[2], qm[3]));
            FOR_BJ { f32x4 pv[2];
#pragma unroll
                for (int n = 0; n < 2; ++n) { const f32x4 a = acc[ai][bj][m][n] * sc; pv[n] = (f32x4){__builtin_amdgcn_exp2f(a[0] - M) * inv, __builtin_amdgcn_exp2f(a[1] - M) * inv, __builtin_amdgcn_exp2f(a[2] - M) * inv, __builtin_amdgcn_exp2f(a[3] - M) * inv}; }
                at<u32x4>(P, ((u.row0 + rl) * D + cb + bj * 128) * 2u) = pk8(pv[0], pv[1]); }
            EPI_FENCE(); } }
    }
};
struct EpiPlain { bf16* O; unsigned pitch;
    __device__ __forceinline__ void operator()(EPI_ARGS) const {
        const unsigned rb = u.row0 + wr * 64 + fr, cb = u.col0 + wc * 32 + 8 * fq;
        FOR_AM { const unsigned row = rb + ai * 128 + m * 16;
            FOR_BJ { at<u32x4>(O, (row * pitch + cb + bj * 128) * 2u) = pk8(acc[ai][bj][m][0], acc[ai][bj][m][1]); }
            EPI_FENCE(); }
    }
};

}

__device__ __forceinline__ void transpose_item(const float* W, int K, int N, const float* gain, bf16* WT, int k0, int n0, int orow0, LAS float* scr, int lane) {
    f32x4 v[16]; const int kr = lane >> 4, c4 = (lane & 15) * 4;
#pragma unroll
    for (int i = 0; i < 16; ++i) v[i] = __builtin_nontemporal_load((const f32x4*)(W + (size_t)(k0 + 4 * i + kr) * N + n0 + c4));
#pragma unroll
    for (int i = 0; i < 16; ++i) { const int kk = 4 * i + kr; const float g = gain ? gain[k0 + kk] : 1.f; LAS float* d = scr + kk * 65 + c4;
        d[0] = v[i][0] * g; d[1] = v[i][1] * g; d[2] = v[i][2] * g; d[3] = v[i][3] * g; }
    LDS_WAIT(); asm volatile("" ::: "memory");
    const int c = lane & 7;
#pragma unroll
    for (int j = 0; j < 8; ++j) { const int n = (lane >> 3) + 8 * j; const LAS float* s = scr + (8 * c) * 65 + n;
        u32x4 o; o.x = pk2(s[0 * 65], s[1 * 65]); o.y = pk2(s[2 * 65], s[3 * 65]); o.z = pk2(s[4 * 65], s[5 * 65]); o.w = pk2(s[6 * 65], s[7 * 65]);
        *(u32x4*)(WT + (size_t)(orow0 + n) * K + k0 + 8 * c) = o; }
    LDS_WAIT(); asm volatile("" ::: "memory");
}

struct Args { const float* in[29]; float* out; unsigned char* ws; int ph_lo, ph_hi; };

__device__ __forceinline__ int map_row(int map, int n0) {
    if (map == 1) return (n0 >> 7) * 256 + (n0 & 127);
    if (map == 2) return (n0 >> 7) * 256 + 128 + (n0 & 127);
    if (map == 3) { if (n0 < D) return n0; if (n0 < 2 * D) { const int j = n0 - D; return D + (j >> 7) * 256 + (j & 127); } const int j = n0 - 2 * D; return D + (j >> 7) * 256 + 128 + (j & 127); }
    return n0;
}

__device__ __forceinline__ void prologue(const Args& a, const int z, LAS unsigned char* lds, int vcu, int G) {
    const int tid = otid(), lane = tid & 63, wave = tid >> 6;
    const int gw = vcu * NWAVES + wave, NGW = G * NWAVES;
    unsigned char* ws = a.ws + z;
    LAS float* scr = (LAS float*)(lds + wave * 16640);
    int off = 0;
    for (int job = 0; job < 26; ++job) {
        const float* W; const float* gain = nullptr; bf16* dst; int K = D, N = D, map = 0;
        if (job < 18) { const int li = job / 9, j = job % 9;
            switch (j) {
                case 0: W = a.in[8 + z] + (size_t)li * D * FF; gain = a.in[7 + z] + li * D; dst = (bf16*)(ws + WS_WGU + (size_t)(li * 2 + 0) * SZ_WGU); N = FF; map = 1; break;
                case 1: W = a.in[9 + z] + (size_t)li * D * FF; gain = a.in[7 + z] + li * D; dst = (bf16*)(ws + WS_WGU + (size_t)(li * 2 + 0) * SZ_WGU); N = FF; map = 2; break;
                case 2: W = a.in[10 + z] + (size_t)li * D * FF; dst = (bf16*)(ws + WS_WD + (size_t)(li * 2 + 0) * SZ_WD); K = FF; break;
                case 3: W = a.in[25 + z] + (size_t)li * D * FF; gain = a.in[24 + z] + li * D; dst = (bf16*)(ws + WS_WGU + (size_t)(li * 2 + 1) * SZ_WGU); N = FF; map = 1; break;
                case 4: W = a.in[26 + z] + (size_t)li * D * FF; gain = a.in[24 + z] + li * D; dst = (bf16*)(ws + WS_WGU + (size_t)(li * 2 + 1) * SZ_WGU); N = FF; map = 2; break;
                case 5: W = a.in[27 + z] + (size_t)li * D * FF; dst = (bf16*)(ws + WS_WD + (size_t)(li * 2 + 1) * SZ_WD); K = FF; break;
                case 6: W = a.in[21 + z] + (size_t)li * D * D; gain = a.in[19 + z] + li * D; dst = (bf16*)(ws + WS_WQ + (size_t)li * SZ_DD); break;
                case 7: W = a.in[22 + z] + (size_t)li * D * 2 * D; gain = a.in[20 + z] + li * D; dst = (bf16*)(ws + WS_WKV + (size_t)li * 2 * SZ_DD); N = 2 * D; break;
                default: W = a.in[23 + z] + (size_t)li * D * D; dst = (bf16*)(ws + WS_WO + (size_t)li * SZ_DD); break;
            }
        } else {
            switch (job) {
                case 18: W = a.in[12 + z]; gain = a.in[11 + z]; dst = (bf16*)(ws + WS_WCI); N = 3 * D; map = 3; break;
                case 19: W = a.in[14 + z]; dst = (bf16*)(ws + WS_WMO); break;
                case 20: W = a.in[16 + z]; gain = a.in[11 + z] + D; dst = (bf16*)(ws + WS_WRI); N = 4 * D; break;
                case 21: W = a.in[18 + z]; dst = (bf16*)(ws + WS_WMO + SZ_DD); break;
                default: W = nullptr; dst = nullptr; break;
            }
        }
        if (!W) continue;
        const int nblk = N / 64, nit = (K / 64) * nblk;
#pragma unroll 1
        for (int it = (gw - off + NGW) % NGW; it < nit; it += NGW) { const int kb = it / nblk, nb = it % nblk;
            transpose_item(W, K, N, gain, dst, kb * 64, nb * 64, map_row(map, nb * 64), scr, lane); }
        off = (off + nit) % NGW;
    }
    bf16* XB = (bf16*)(ws + WS_XB); float* SSQ = (float*)(ws + WS_SSQ);
#pragma unroll 1
    for (int m = gw; m < MT; m += 2 * NGW) {
        const int m2 = m + NGW; const bool has2 = m2 < MT;
        const f32x4* xr = (const f32x4*)(m < MP ? a.in[0 + z] + (size_t)m * D : a.in[1 + z] + (size_t)(m - MP) * D) + lane;
        const f32x4* xr2 = (const f32x4*)(!has2 ? (const float*)xr - 4 * lane : (m2 < MP ? a.in[0 + z] + (size_t)m2 * D : a.in[1 + z] + (size_t)(m2 - MP) * D)) + lane;
        f32x4 v[4], v2[4];
#pragma unroll
        for (int j = 0; j < 4; ++j) { v[j] = __builtin_nontemporal_load(xr + 64 * j); v2[j] = __builtin_nontemporal_load(xr2 + 64 * j); }
        float s = 0.f, s2 = 0.f;
#pragma unroll
        for (int j = 0; j < 4; ++j) { s += (v[j][0] * v[j][0] + v[j][1] * v[j][1]) + (v[j][2] * v[j][2] + v[j][3] * v[j][3]); s2 += (v2[j][0] * v2[j][0] + v2[j][1] * v2[j][1]) + (v2[j][2] * v2[j][2] + v2[j][3] * v2[j][3]);
            ((u32x2*)(XB + (size_t)m * D))[lane + 64 * j] = pg8::pk4(v[j]); if (has2) ((u32x2*)(XB + (size_t)m2 * D))[lane + 64 * j] = pg8::pk4(v2[j]); }
        s = wave_sum(s); s2 = wave_sum(s2); if (lane == 0) { ((unsigned*)SSQ)[m] = (unsigned)(s * pg8::SSQ_FX + 0.5f); if (has2) ((unsigned*)SSQ)[m2] = (unsigned)(s2 * pg8::SSQ_FX + 0.5f); }
    }
    for (int i = gw * 64 + lane; i < 2 * D * D / 8; i += NGW * 64) { const int l = i >> 17, e0 = (i & 131071) * 8, kk = e0 >> 10;
        const float g = a.in[19 + z][l * D + kk]; const f32x4* p = (const f32x4*)(a.in[21 + z] + (size_t)l * D * D + e0); const f32x4 v0 = p[0] * g, v1 = p[1] * g;
        u32x4 o; o.x = pk2(v0[0], v0[1]); o.y = pk2(v0[2], v0[3]); o.z = pk2(v1[0], v1[1]); o.w = pk2(v1[2], v1[3]);
        *(u32x4*)((bf16*)(ws + WS_WQN) + (size_t)l * D * D + e0) = o; }
    bf16* MEMB = (bf16*)(ws + WS_MEMB); float* MSSQ = (float*)(ws + WS_MSSQ);
    for (int m = gw; m < MEMR; m += NGW) { const f32x4* xr = (const f32x4*)(a.in[2 + z] + (size_t)m * D) + lane; float s = 0.f;
#pragma unroll
        for (int j = 0; j < 4; ++j) { const f32x4 v = xr[64 * j]; s += (v[0] * v[0] + v[1] * v[1]) + (v[2] * v[2] + v[3] * v[3]); u32x2 w; w.x = pk2(v[0], v[1]); w.y = pk2(v[2], v[3]); ((u32x2*)(MEMB + (size_t)m * D))[lane + 64 * j] = w; }
        s = wave_sum(s); if (lane == 0) MSSQ[m] = s; }
    for (int i = vcu * NTHR + tid; i < 8 * MPAD; i += G * NTHR) SSQ[MPAD + i] = 0.f;
}

__device__ __forceinline__ void ld8(const bf16* p, float (&f)[8]) { const u32x4 w = *(const u32x4*)p; f[0] = bflo(w.x); f[1] = bfhi(w.x); f[2] = bflo(w.y); f[3] = bfhi(w.y); f[4] = bflo(w.z); f[5] = bfhi(w.z); f[6] = bflo(w.w); f[7] = bfhi(w.w); }
__device__ __forceinline__ void up8(const u32x4 w, float (&f)[8]) { f[0] = bflo(w.x); f[1] = bfhi(w.x); f[2] = bflo(w.y); f[3] = bfhi(w.y); f[4] = bflo(w.z); f[5] = bfhi(w.z); f[6] = bflo(w.w); f[7] = bfhi(w.w); }
__device__ __forceinline__ void conv_phase(const Args& a, const int z, int vcu, int G) {
    unsigned char* ws = a.ws + z; const bf16* CB = (const bf16*)(ws + WS_M1); const bf16* CV = (const bf16*)(ws + WS_M2); bf16* Gb = (bf16*)(ws + WS_G);
    const float* wc = a.in[13 + z]; const float* st = a.in[3 + z]; float* out_cs = a.out + OUT_CS;
    const int nth = G * NTHR, gt = vcu * NTHR + otid(), ch = (gt & 127) * 8;
    float w0[8], w1[8], w2[8];
#pragma unroll
    for (int e = 0; e < 8; ++e) { w0[e] = wc[ch + e]; w1[e] = wc[D + ch + e]; w2[e] = wc[2 * D + ch + e]; }
    if ((nth & 127) == 0) {
#pragma unroll 1
        for (int it0 = gt; it0 < MP * 128; it0 += 4 * nth) {
            u32x4 B[4], V2[4], V1[4], V0[4];
#pragma unroll
            for (int j = 0; j < 4; ++j) { const int it = it0 + j * nth; const int row = it < MP * 128 ? (it >> 7) : 0; const int t = row & (T - 1);
                B[j] = *(const u32x4*)(CB + (size_t)row * D + ch); V2[j] = *(const u32x4*)(CV + (size_t)row * D + ch);
                V1[j] = *(const u32x4*)(CV + (size_t)(row - (t >= 1 ? 1 : 0)) * D + ch); V0[j] = *(const u32x4*)(CV + (size_t)(row - (t >= 2 ? 2 : 0)) * D + ch); }
#pragma unroll
            for (int j = 0; j < 4; ++j) { const int it = it0 + j * nth; if (it < MP * 128) { const int row = it >> 7, t = row & (T - 1);
                float b[8], v2[8], v1[8], v0[8], g[8]; up8(B[j], b); up8(V2[j], v2); up8(V1[j], v1); up8(V0[j], v0);
                const float m1 = t >= 1 ? 1.f : 0.f, m0 = t >= 2 ? 1.f : 0.f;
#pragma unroll
                for (int e = 0; e < 8; ++e) g[e] = b[e] * (w0[e] * (v0[e] * m0) + w1[e] * (v1[e] * m1) + w2[e] * v2[e]);
                u32x4 w; w.x = pk2(g[0], g[1]); w.y = pk2(g[2], g[3]); w.z = pk2(g[4], g[5]); w.w = pk2(g[6], g[7]);
                *(u32x4*)(Gb + (size_t)row * D + ch) = w; } }
        }
        if (gt < NS * 128) { const int s = gt >> 7, row = MP + s; float b[8], v2[8], g[8];
            ld8(CB + (size_t)row * D + ch, b); ld8(CV + (size_t)row * D + ch, v2);
            const f32x4* p0 = (const f32x4*)(st + ((size_t)s * 2 + 0) * D + ch); const f32x4* p1 = (const f32x4*)(st + ((size_t)s * 2 + 1) * D + ch);
            const f32x4 a0 = p0[0], a1 = p0[1], b0 = p1[0], b1 = p1[1];
            f32x4* o = (f32x4*)(out_cs + ((size_t)s * 2 + 0) * D + ch); o[0] = b0; o[1] = b1;
#pragma unroll
            for (int e = 0; e < 8; ++e) { const float x0 = e < 4 ? a0[e & 3] : a1[e & 3], x1 = e < 4 ? b0[e & 3] : b1[e & 3]; g[e] = b[e] * (w0[e] * x0 + w1[e] * x1 + w2[e] * v2[e]); }
            u32x4 w; w.x = pk2(g[0], g[1]); w.y = pk2(g[2], g[3]); w.z = pk2(g[4], g[5]); w.w = pk2(g[6], g[7]);
            *(u32x4*)(Gb + (size_t)row * D + ch) = w; }
        return;
    }
    for (int it = gt; it < MT * 128; it += nth) {
        const int row = it >> 7, chx = (it & 127) * 8; float b[8], v2[8], v1[8], v0[8];
        ld8(CB + (size_t)row * D + chx, b); ld8(CV + (size_t)row * D + chx, v2);
        if (row < MP) { const int t = row & (T - 1);
            if (t >= 1) ld8(CV + (size_t)(row - 1) * D + chx, v1); else { for (int e = 0; e < 8; ++e) v1[e] = 0.f; }
            if (t >= 2) ld8(CV + (size_t)(row - 2) * D + chx, v0); else { for (int e = 0; e < 8; ++e) v0[e] = 0.f; }
        } else { const int s = row - MP; const f32x4* p0 = (const f32x4*)(st + ((size_t)s * 2 + 0) * D + chx); const f32x4* p1 = (const f32x4*)(st + ((size_t)s * 2 + 1) * D + chx);
            const f32x4 a0 = p0[0], a1 = p0[1], b0 = p1[0], b1 = p1[1];
            for (int e = 0; e < 4; ++e) { v0[e] = a0[e]; v0[4 + e] = a1[e]; v1[e] = b0[e]; v1[4 + e] = b1[e]; }
            f32x4* o = (f32x4*)(out_cs + ((size_t)s * 2 + 0) * D + chx); o[0] = b0; o[1] = b1; }
        float g[8];
#pragma unroll
        for (int e = 0; e < 8; ++e) g[e] = b[e] * (wc[chx + e] * v0[e] + wc[D + chx + e] * v1[e] + wc[2 * D + chx + e] * v2[e]);
        u32x4 w; w.x = pk2(g[0], g[1]); w.y = pk2(g[2], g[3]); w.z = pk2(g[4], g[5]); w.w = pk2(g[6], g[7]);
        *(u32x4*)(Gb + (size_t)row * D + chx) = w;
    }
}

__device__ __forceinline__ void sample_attn_unit(LAS unsigned char* lds, const float* Kc, const float* Vc, const bf16* Q, bf16* O, int s, int hp) {
    const int tid = otid(), lane = tid & 63, w = tid >> 6;
    LAS float* qs = (LAS float*)lds; LAS float* sc = qs + 512; LAS float* red = sc + 512;
    qs[tid] = bf2f(Q[(size_t)(MP + s) * D + hp * 512 + tid]);
    __syncthreads();
    const f32x4 qa = *(LAS f32x4*)(qs + 4 * lane), qb = *(LAS f32x4*)(qs + 256 + 4 * lane);
    const float* Kb = Kc + ((size_t)s * NMEM * 4 + hp * 2) * 256 + 4 * lane;
    for (int j = 0; j < 32; j += 8) {
        f32x4 ka[8], kb[8];
#pragma unroll
        for (int jj = 0; jj < 8; ++jj) { const int n = w + 8 * (j + jj); ka[jj] = __builtin_nontemporal_load((const f32x4*)(Kb + (size_t)n * 1024)); kb[jj] = __builtin_nontemporal_load((const f32x4*)(Kb + (size_t)n * 1024 + 256)); }
#pragma unroll
        for (int jj = 0; jj < 8; ++jj) { const int n = w + 8 * (j + jj);
            float pa = (qa[0] * ka[jj][0] + qa[1] * ka[jj][1]) + (qa[2] * ka[jj][2] + qa[3] * ka[jj][3]);
            float pb = (qb[0] * kb[jj][0] + qb[1] * kb[jj][1]) + (qb[2] * kb[jj][2] + qb[3] * kb[jj][3]);
            pa = wave_sum(pa); pb = wave_sum(pb);
            if (lane == 0) { sc[n] = pa; sc[256 + n] = pb; } }
    }
    __syncthreads();
    if (w < 2) { LAS float* p = sc + 256 * w; float v[4]; float m = -3.0e38f;
#pragma unroll
        for (int i = 0; i < 4; ++i) { v[i] = p[lane + 64 * i]; m = fmaxf(m, v[i]); }
        m = wave_max(m); float sum = 0.f;
#pragma unroll
        for (int i = 0; i < 4; ++i) { v[i] = __builtin_amdgcn_exp2f(v[i] - m); sum += v[i]; }
        sum = wave_sum(sum); const float inv = 1.f / sum;
#pragma unroll
        for (int i = 0; i < 4; ++i) p[lane + 64 * i] = v[i] * inv; }
    __syncthreads();
    const int dq = tid & 127, ng = tid >> 7, hsel = dq >> 6;
    const float* Vb = Vc + ((size_t)s * NMEM * 4 + hp * 2) * 256 + 4 * dq;
    f32x4 acc = (f32x4){0.f, 0.f, 0.f, 0.f};
#pragma unroll 16
    for (int j = 0; j < 64; ++j) { const int n = ng + 4 * j; const float p = sc[hsel * 256 + n]; const f32x4 v = __builtin_nontemporal_load((const f32x4*)(Vb + (size_t)n * 1024)); acc += v * p; }
    *(LAS f32x4*)(red + ng * 512 + 4 * dq) = acc;
    __syncthreads();
    if (tid < 128) { f32x4 o = *(LAS f32x4*)(red + 4 * tid) + *(LAS f32x4*)(red + 512 + 4 * tid) + *(LAS f32x4*)(red + 1024 + 4 * tid) + *(LAS f32x4*)(red + 1536 + 4 * tid);
        u32x2 wv; wv.x = pk2(o[0], o[1]); wv.y = pk2(o[2], o[3]); *(u32x2*)(O + (size_t)(MP + s) * D + hp * 512 + 4 * tid) = wv; }
    __syncthreads();
}

__device__ __forceinline__ void sample_rec_unit(LAS unsigned char* lds, const Args& a, const int z, int s, int h) {
    const int tid = otid(), lane = tid & 63, w = tid >> 6;
    unsigned char* ws = a.ws + z; const bf16* RQ = (const bf16*)(ws + WS_M1); const bf16* RI = (const bf16*)(ws + WS_M2); const bf16* RG = (const bf16*)(ws + WS_RG); const _Float16* LOGF = (const _Float16*)(ws + WS_LOGF);
    bf16* GO = (bf16*)(ws + WS_G);
    LAS float* fL = (LAS float*)lds; LAS float* kL = fL + 128; LAS float* qL = kL + 128; LAS float* iL = qL + 128; LAS float* red = iL + 128; LAS float* tmp = red + 16 * 128;
    const size_t rbase = (size_t)(MP + s) * D + h * 128;
    if (tid < 128) { const float f = (float)LOGF[rbase + tid]; fL[tid] = f; kL[tid] = 1.f - f; qL[tid] = bf2f(RQ[rbase + tid]); iL[tid] = bf2f(RI[rbase + tid]); }
    __syncthreads();
    const int vq = tid & 31, kq = tid >> 5;
    const f32x4 iv = *(LAS f32x4*)(iL + 4 * vq); f32x4 o = (f32x4){0.f, 0.f, 0.f, 0.f};
    const size_t sb = ((size_t)(s * 8 + h) * 128) * 128;
    const float* S0 = a.in[4 + z] + sb; float* So = a.out + OUT_RS + sb;
    f32x4 s0v[8];
#pragma unroll
    for (int j = 0; j < 8; ++j) s0v[j] = __builtin_nontemporal_load((const f32x4*)(S0 + (kq + 16 * j) * 128 + 4 * vq));
#pragma unroll
    for (int j = 0; j < 8; ++j) { const int k = kq + 16 * j; const f32x4 sn = s0v[j] * fL[k] + iv * kL[k];
        *(f32x4*)(So + k * 128 + 4 * vq) = sn; o += sn * qL[k]; }
    *(LAS f32x4*)(red + kq * 128 + 4 * vq) = o;
    __syncthreads();
    float ov = 0.f;
    if (tid < 128) {
#pragma unroll
        for (int j = 0; j < 16; ++j) ov += red[j * 128 + tid];
        const float ss = wave_sum(ov * ov); if (lane == 0) tmp[w] = ss; }
    __syncthreads();
    if (tid < 128) { const float rstd = rsqrtf((tmp[0] + tmp[1]) * (1.f / 128.f) + EPS);
        GO[rbase + tid] = (bf16)f2bf(ov * rstd * a.in[17 + z][tid] * bf2f(RG[rbase + tid])); }
    __syncthreads();
}

__device__ __forceinline__ f32x4 mfma16(bf16x8 a, bf16x8 b, f32x4 c) { return __builtin_amdgcn_mfma_f32_16x16x32_bf16(a, b, c, 0, 0, 0); }
constexpr int G1_QB = 0, G1_KI = 17408, G1_KL = 34816, G1_VT = 53248, G1_AT = 71680, G1_TOT = 80896;
struct G1In { float f[16]; unsigned q[16]; unsigned v[16]; };
__device__ __forceinline__ void gla_g1_load(unsigned char* ws, int unit, int tid, G1In& in) {
    const _Float16* FG = (const _Float16*)(ws + WS_LOGF); const bf16* RQ = (const bf16*)(ws + WS_M1); const bf16* RI = (const bf16*)(ws + WS_M2);
    const int bh = unit >> 5, c = unit & 31, b = bh >> 3, h = bh & 7, row0 = b * T + c * 64;
    const size_t gb = (size_t)(row0 + 16 * (tid >> 7)) * D + h * 128 + (tid & 127);
#pragma unroll
    for (int j = 0; j < 16; ++j) { in.f[j] = (float)FG[gb + (size_t)j * D]; in.q[j] = RQ[gb + (size_t)j * D]; in.v[j] = RI[gb + (size_t)j * D]; }
}
#define G1_BAR() do { LDS_WAIT(); __builtin_amdgcn_s_barrier(); asm volatile("" ::: "memory"); } while (0)
__device__ __forceinline__ void gla_g1_compute(LAS unsigned char* lds, unsigned char* ws, int unit, int tid, const G1In& in) {
    const int lane = tid & 63, w = tid >> 6, r = lane & 15, q = lane >> 4;
    bf16* QBG = (bf16*)(ws + WS_QBG); bf16* OINTRA = (bf16*)(ws + WS_OINTRA); bf16* UT = (bf16*)(ws + WS_UT); float* DEC = (float*)(ws + WS_DEC);
    const int bh = unit >> 5, c = unit & 31, b = bh >> 3, h = bh & 7, row0 = b * T + c * 64, colh = h * 128;
    LAS bf16* QbL = (LAS bf16*)(lds + G1_QB); LAS bf16* KiL = (LAS bf16*)(lds + G1_KI); LAS bf16* KlT = (LAS bf16*)(lds + G1_KL); LAS bf16* vT = (LAS bf16*)(lds + G1_VT); LAS bf16* atL = (LAS bf16*)(lds + G1_AT);
    LAS float* tot = (LAS float*)(lds + G1_TOT);
    const int k = tid & 127, part = tid >> 7, t0 = 16 * part;
    float pc[16]; float run = 1.f;
#pragma unroll
    for (int j = 0; j < 16; ++j) { run *= in.f[j]; pc[j] = run; }
    tot[part * 128 + k] = run;
    G1_BAR();
    float offp = 1.f, eL = 1.f;
#pragma unroll
    for (int p = 0; p < 4; ++p) { const float tv = tot[p * 128 + k]; eL *= tv; if (p < part) offp *= tv; }
    unsigned kl[8];
#pragma unroll
    for (int j = 0; j < 16; j += 2) {
        const float e0 = pc[j] * offp, e1 = pc[j + 1] * offp, i0 = __builtin_amdgcn_rcpf(e0), i1 = __builtin_amdgcn_rcpf(e1);
        const float ki0 = (1.f - in.f[j]) * i0, ki1 = (1.f - in.f[j + 1]) * i1;
        const unsigned qb = pk2(bf2f(in.q[j]) * e0, bf2f(in.q[j + 1]) * e1), ki = pk2(ki0, ki1);
        QbL[(t0 + j) * 136 + k] = (bf16)(qb & 0xffffu); QbL[(t0 + j + 1) * 136 + k] = (bf16)(qb >> 16);
        KiL[(t0 + j) * 136 + k] = (bf16)(ki & 0xffffu); KiL[(t0 + j + 1) * 136 + k] = (bf16)(ki >> 16);
        kl[j >> 1] = pk2(ki0 * eL, ki1 * eL); }
    { u32x4 w0, w1; w0.x = kl[0]; w0.y = kl[1]; w0.z = kl[2]; w0.w = kl[3]; w1.x = kl[4]; w1.y = kl[5]; w1.z = kl[6]; w1.w = kl[7];
      *(LAS u32x4*)(KlT + k * 72 + t0) = w0; *(LAS u32x4*)(KlT + k * 72 + t0 + 8) = w1;
      w0.x = in.v[0] | (in.v[1] << 16); w0.y = in.v[2] | (in.v[3] << 16); w0.z = in.v[4] | (in.v[5] << 16); w0.w = in.v[6] | (in.v[7] << 16);
      w1.x = in.v[8] | (in.v[9] << 16); w1.y = in.v[10] | (in.v[11] << 16); w1.z = in.v[12] | (in.v[13] << 16); w1.w = in.v[14] | (in.v[15] << 16);
      *(LAS u32x4*)(vT + k * 72 + t0) = w0; *(LAS u32x4*)(vT + k * 72 + t0 + 8) = w1; }
    if (part == 0) DEC[(size_t)unit * 128 + k] = eL;
    G1_BAR();
#pragma unroll
    for (int i = 0; i < 2; ++i) { const int idx = tid + 512 * i, t = idx >> 4, c16 = idx & 15; *(u32x4*)(QBG + (size_t)(row0 + t) * D + colh + 8 * c16) = *(const LAS u32x4*)(QbL + t * 136 + 8 * c16); }
    { const int ti = w >> 1;
#pragma unroll
      for (int sx = 0; sx < 2; ++sx) { const int sj = 2 * (w & 1) + sx; f32x4 acc = (f32x4){0.f, 0.f, 0.f, 0.f};
        if (sj <= ti) {
#pragma unroll
        for (int ks = 0; ks < 4; ++ks) { const bf16x8 av = *(const LAS bf16x8*)(QbL + (16 * ti + r) * 136 + 32 * ks + 8 * q); const bf16x8 bv = *(const LAS bf16x8*)(KiL + (16 * sj + r) * 136 + 32 * ks + 8 * q); acc = mfma16(av, bv, acc); } }
#pragma unroll
        for (int e = 0; e < 4; ++e) { const int t = 16 * ti + 4 * q + e, s = 16 * sj + r; atL[t * 72 + s] = (bf16)f2bf(s <= t ? acc[e] : 0.f); } } }
    G1_BAR();
    { const int tj = w & 3;
#pragma unroll
      for (int vx = 0; vx < 4; ++vx) { const int vi = 4 * (w >> 2) + vx; f32x4 acc = (f32x4){0.f, 0.f, 0.f, 0.f};
#pragma unroll
        for (int ks = 0; ks < 2; ++ks) { const bf16x8 av = *(const LAS bf16x8*)(vT + (16 * vi + r) * 72 + 32 * ks + 8 * q); const bf16x8 bv = *(const LAS bf16x8*)(atL + (16 * tj + r) * 72 + 32 * ks + 8 * q); acc = mfma16(av, bv, acc); }
        *(u32x2*)(OINTRA + (size_t)(row0 + 16 * tj + r) * D + colh + 16 * vi + 4 * q) = pg8::pk4(acc); } }
    { const int vj = w;
#pragma unroll
      for (int ki = 0; ki < 8; ++ki) { f32x4 acc = (f32x4){0.f, 0.f, 0.f, 0.f};
#pragma unroll
        for (int ks = 0; ks < 2; ++ks) { const bf16x8 av = *(const LAS bf16x8*)(KlT + (16 * ki + r) * 72 + 32 * ks + 8 * q); const bf16x8 bv = *(const LAS bf16x8*)(vT + (16 * vj + r) * 72 + 32 * ks + 8 * q); acc = mfma16(av, bv, acc); }
        *(u32x2*)(UT + (size_t)unit * 16384 + (size_t)(16 * vj + r) * 128 + 16 * ki + 4 * q) = pg8::pk4(acc); } }
    G1_BAR();
}
__device__ __forceinline__ void gla_g1_phase(LAS unsigned char* lds, unsigned char* ws, int bx, int G) {
    const int tid = otid(); G1In cur, nxt;
    if (bx < 2048) gla_g1_load(ws, bx, tid, cur);
#pragma unroll 1
    for (int u = bx; u < 2048; u += G) { const int un = u + G;
        if (un < 2048) gla_g1_load(ws, un, tid, nxt);
        gla_g1_compute(lds, ws, u, tid, cur);
        cur = nxt; }
    asm volatile("s_waitcnt vmcnt(0)" ::: "memory"); __syncthreads();
}
__device__ __forceinline__ void gla_g2(const Args& a, const int z, int vcu, int G) {
    unsigned char* ws = a.ws + z; const bf16* UT = (const bf16*)(ws + WS_UT); const float* DEC = (const float*)(ws + WS_DEC); bf16* SPT = (bf16*)(ws + WS_SPT); float* outp = a.out + OUT_RP;
    for (int it = vcu * NTHR + otid(); it < 64 * 128 * 32; it += G * NTHR) {
        const int k4 = it & 31, v = (it >> 5) & 127, bh = it >> 12; f32x4 S = (f32x4){0.f, 0.f, 0.f, 0.f};
        const size_t eo = (size_t)v * 128 + 4 * k4;
#pragma unroll 1
        for (int c0 = 0; c0 < 32; c0 += 8) { u32x2 uw[8]; f32x4 dd[8];
#pragma unroll
            for (int j = 0; j < 8; ++j) { const size_t unit = (size_t)bh * 32 + c0 + j; uw[j] = *(const u32x2*)(UT + unit * 16384 + eo); dd[j] = *(const f32x4*)(DEC + unit * 128 + 4 * k4); }
#pragma unroll
            for (int j = 0; j < 8; ++j) { const size_t unit = (size_t)bh * 32 + c0 + j; const f32x4 uu = (f32x4){bflo(uw[j].x), bfhi(uw[j].x), bflo(uw[j].y), bfhi(uw[j].y)};
                u32x2 wv; wv.x = pk2(S[0], S[1]); wv.y = pk2(S[2], S[3]); *(u32x2*)(SPT + unit * 16384 + eo) = wv;
                S = S * dd[j] + uu; } }
#pragma unroll
        for (int e = 0; e < 4; ++e) outp[((size_t)bh * 128 + 4 * k4 + e) * 128 + v] = S[e];
    }
}
__device__ __forceinline__ void gla_g3_phase(LAS unsigned char* lds, const Args& a, const int z, int bx, int G) {
    const int tid = otid(), lane = tid & 63, w = tid >> 6, r = lane & 15, q = lane >> 4;
    unsigned char* ws = a.ws + z; const bf16* QBG = (const bf16*)(ws + WS_QBG); const bf16* SPT = (const bf16*)(ws + WS_SPT); const bf16* OINTRA = (const bf16*)(ws + WS_OINTRA);
    const bf16* RG = (const bf16*)(ws + WS_RG); bf16* GO = (bf16*)(ws + WS_G); const float* gon = a.in[17 + z];
    constexpr int BUFB = 17408 + 34816 + 512;
    u32x4 pq[2], ps[4];
    { const int u = bx, bh = u >> 5, c = u & 31, row0 = (bh >> 3) * T + c * 64, colh = (bh & 7) * 128;
#pragma unroll
      for (int i = 0; i < 2; ++i) { const int idx = tid + 512 * i; pq[i] = *(const u32x4*)(QBG + (size_t)(row0 + (idx >> 4)) * D + colh + 8 * (idx & 15)); }
#pragma unroll
      for (int i = 0; i < 4; ++i) { const int idx = tid + 512 * i; ps[i] = *(const u32x4*)(SPT + (size_t)u * 16384 + (idx >> 4) * 128 + 8 * (idx & 15)); } }
    int par = 0;
#pragma unroll 1
    for (int u = bx; u < 2048; u += G, par ^= 1) {
        LAS bf16* QbL = (LAS bf16*)(lds + par * BUFB); LAS bf16* SL = (LAS bf16*)(lds + par * BUFB + 17408); LAS float* ssL = (LAS float*)(lds + par * BUFB + 17408 + 34816);
        const int bh = u >> 5, c = u & 31, row0 = (bh >> 3) * T + c * 64, colh = (bh & 7) * 128;
#pragma unroll
        for (int i = 0; i < 2; ++i) { const int idx = tid + 512 * i; *(LAS u32x4*)(QbL + (idx >> 4) * 136 + 8 * (idx & 15)) = pq[i]; }
#pragma unroll
        for (int i = 0; i < 4; ++i) { const int idx = tid + 512 * i; *(LAS u32x4*)(SL + (idx >> 4) * 136 + 8 * (idx & 15)) = ps[i]; }
        G1_BAR();
        const int un = u + G;
        if (un < 2048) { const int bh2 = un >> 5, c2 = un & 31, row2 = (bh2 >> 3) * T + c2 * 64, colh2 = (bh2 & 7) * 128;
#pragma unroll
            for (int i = 0; i < 2; ++i) { const int idx = tid + 512 * i; pq[i] = *(const u32x4*)(QBG + (size_t)(row2 + (idx >> 4)) * D + colh2 + 8 * (idx & 15)); }
#pragma unroll
            for (int i = 0; i < 4; ++i) { const int idx = tid + 512 * i; ps[i] = *(const u32x4*)(SPT + (size_t)un * 16384 + (idx >> 4) * 128 + 8 * (idx & 15)); } }
        const int tj = w & 3, vh = w >> 2, t = 16 * tj + r; f32x4 o[4]; float ss = 0.f;
        u32x2 ow[4], rg[4];
#pragma unroll
        for (int vx = 0; vx < 4; ++vx) { const size_t off = (size_t)(row0 + t) * D + colh + 16 * (4 * vh + vx) + 4 * q; ow[vx] = *(const u32x2*)(OINTRA + off); rg[vx] = *(const u32x2*)(RG + off); }
#pragma unroll
        for (int vx = 0; vx < 4; ++vx) { const int vi = 4 * vh + vx; f32x4 acc = (f32x4){bflo(ow[vx].x), bfhi(ow[vx].x), bflo(ow[vx].y), bfhi(ow[vx].y)};
#pragma unroll
            for (int ks = 0; ks < 4; ++ks) { const bf16x8 av = *(const LAS bf16x8*)(SL + (16 * vi + r) * 136 + 32 * ks + 8 * q); const bf16x8 bv = *(const LAS bf16x8*)(QbL + (16 * tj + r) * 136 + 32 * ks + 8 * q); acc = mfma16(av, bv, acc); }
            o[vx] = acc; ss += (acc[0] * acc[0] + acc[1] * acc[1]) + (acc[2] * acc[2] + acc[3] * acc[3]); }
        ss += __shfl_xor(ss, 16); ss += __shfl_xor(ss, 32);
        if (q == 0) ssL[vh * 64 + t] = ss;
        G1_BAR();
        const float rstd = rsqrtf((ssL[t] + ssL[64 + t]) * (1.f / 128.f) + EPS);
#pragma unroll
        for (int vx = 0; vx < 4; ++vx) { const int v0 = 16 * (4 * vh + vx) + 4 * q; const f32x4 gn = *(const f32x4*)(gon + v0); const size_t off = (size_t)(row0 + t) * D + colh + v0;
            u32x2 wv; wv.x = pk2(o[vx][0] * rstd * gn[0] * bflo(rg[vx].x), o[vx][1] * rstd * gn[1] * bfhi(rg[vx].x)); wv.y = pk2(o[vx][2] * rstd * gn[2] * bflo(rg[vx].y), o[vx][3] * rstd * gn[3] * bfhi(rg[vx].y));
            *(u32x2*)(GO + off) = wv; }
    }
    asm volatile("s_waitcnt vmcnt(0)" ::: "memory"); __syncthreads();
}

__device__ __forceinline__ int opaque_v0() { int z; asm volatile("v_mov_b32 %0, 0" : "=v"(z)); return z; }
__device__ __forceinline__ int opaque0() { int z; asm volatile("s_mov_b32 %0, 0" : "=s"(z)); return z; }
#define INP(i) (a.in[(i) + z])
constexpr int NSTEPS = 29;
struct GemmDesc { const char* A; const char* B; int lda, ldb, K, M, N; size_t bstride; };
__device__ __forceinline__ void gemm_desc(const Args& a, int gs, bool smp, GemmDesc& d) {
    unsigned char* ws = a.ws; const int li = gs >= 15 ? 1 : 0, st = gs - 2 - 13 * li;
    d.lda = D; d.ldb = D; d.K = D; d.M = MP; d.N = D; d.bstride = 0; d.A = (const char*)(ws + WS_XB);
    if (st == 0 || st == 11) { d.B = (const char*)(ws + WS_WGU + (size_t)(li * 2 + (st == 11)) * SZ_WGU); d.N = 2 * FF; d.M = MPAD; }
    else if (st == 1 || st == 12) { d.A = (const char*)(ws + WS_H); d.B = (const char*)(ws + WS_WD + (size_t)(li * 2 + (st == 12)) * SZ_WD); d.K = FF; d.lda = FF; d.ldb = FF; }
    else if (st == 2) { d.B = li == 0 ? (const char*)(ws + WS_WCI) : (const char*)(ws + WS_WRI); d.N = li == 0 ? 3 * D : 4 * D; }
    else if (st == 6) { d.A = (const char*)(ws + WS_G); d.B = (const char*)(ws + WS_WMO + (size_t)li * SZ_DD); }
    else if (st == 7) { if (smp) d.B = (const char*)(ws + WS_WQ + (size_t)li * SZ_DD); else { d.B = (const char*)(ws + WS_WQK + (size_t)li * 8 * SZ_DD); d.bstride = SZ_DD; } }
    else if (st == 8) { d.A = (const char*)(ws + WS_P); d.B = (const char*)(ws + WS_VWT + (size_t)li * 8 * SZ_DD); d.ldb = 8 * D; d.bstride = (size_t)D * 2; }
    else { d.A = (const char*)(ws + WS_O); d.B = (const char*)(ws + WS_WO + (size_t)li * SZ_DD); }
}
namespace pg8 {
struct SchedAny { const Args& a; int gs, G, c;
    __device__ __forceinline__ bool next(int i, Unit& u) const {
        const int g2 = gs + opaque0(); GemmDesc d; gemm_desc(a, g2, false, d);
        Sched2D s; s.A = d.A; s.B = d.B; s.bstride = d.bstride; s.lda = d.lda; s.ldb = d.ldb; s.nM = d.M / BM; s.nN = d.N / BM; s.nwg = s.nM * s.nN; s.G = G; s.c = c;
        u.nt = d.K / BK; u.kind = 0;
        const int j = i * G + c - s.nwg; unsigned char* ws = a.ws;
        if (g2 == 2 || g2 == 13) {
            const int L = i * G + c;
            if (L >= 64) { const int L2 = L - 64; s.c = L2 % G; return s.next(L2 / G, u); }
            const int pm = L & 7, pn = L >> 3;
            u.A = (const char*)(ws + WS_MEMB) + (size_t)pm * BM * D * 2; u.B = (const char*)(ws + WS_WKV + (size_t)(g2 == 13) * 2 * SZ_DD) + (size_t)pn * BM * D * 2;
            u.row0 = pm * BM; u.col0 = 8192 + pn * BM; return true; }
        if ((g2 == 4 || g2 == 17) && j >= 0 && j < 256) {
            const int l = g2 == 17, which = j >> 7, jj = j & 127, b = jj >> 4, h = (jj >> 2) & 3, t4 = jj & 3; u.nt = 4;
            if (which == 0) { u.kind = 1; u.A = (const char*)(ws + WS_MEMK + (size_t)l * MEMR * D * 2) + ((size_t)(b * NMEM) * D + h * 256) * 2; u.B = (const char*)(ws + WS_WQN + (size_t)l * SZ_DD) + ((size_t)(t4 * 256) * D + h * 256) * 2;
                u.row0 = b * 1024 + h * 256; u.col0 = t4 * 256; }
            else { u.kind = 2; u.A = (const char*)(ws + WS_WO + (size_t)l * SZ_DD) + ((size_t)(t4 * 256) * D + h * 256) * 2; u.B = (const char*)(ws + WS_VT + (size_t)l * MEMR * D * 2) + ((size_t)(b * NMEM) * D + h * 256) * 2;
                u.row0 = t4 * 256; u.col0 = b * 1024 + h * 256; }
            return true; }
        return s.next(i, u);
    }
};
struct EpiAny { const Args& a; int gs0; LAS float* scr;
    __device__ __forceinline__ void operator()(const Acc& acc, const Unit& u, int wr, int wc, int fr_, int fq_) const {
        const int ov = opaque_v0(); const int fr = fr_ + ov, fq = fq_ + ov;
        const int z = opaque0(); const int gs = gs0 + z; unsigned char* ws = a.ws + z; float* SSQ = (float*)(ws + WS_SSQ);
        const int li = gs >= 15 ? 1 : 0, st = gs - 2 - 13 * li;
        if (u.kind == 1) { EpiPlain e{(bf16*)(ws + WS_WQK + (size_t)li * 8 * SZ_DD), (unsigned)D}; e(acc, u, wr, wc, fr, fq); }
        else if (u.kind == 2) { EpiPlain e{(bf16*)(ws + WS_VWT + (size_t)li * 8 * SZ_DD), (unsigned)(8 * D)}; e(acc, u, wr, wc, fr, fq); }
        else if ((st == 0 || st == 11) && u.col0 >= 8192) { const int l = st == 11; Unit v = u; v.col0 = u.col0 - 8192; const size_t lo = (size_t)l * MEMR * D;
            EpiKV e{a.out + OUT_MK + lo, a.out + OUT_MV + lo, (bf16*)(ws + WS_MEMK) + lo, (bf16*)(ws + WS_VT) + lo, (const float*)(ws + WS_MSSQ)}; e(acc, v, wr, wc, fr, fq); }
        else if (st == 0 || st == 11) { EpiGU e{(bf16*)(ws + WS_H), SSQ + (size_t)(li * 4 + (st == 11 ? 3 : 0)) * MPAD}; e(acc, u, wr, wc, fr, fq); }
        else if (st == 1 || st == 12 || st == 6 || st == 8) { const int so = li * 4 + (st == 1 ? 1 : st == 6 ? 2 : st == 8 ? 3 : 4);
            EpiRes e{gs == 3 ? INP(0) : (const float*)nullptr, (bf16*)(ws + WS_XB), SSQ + (size_t)so * MPAD, (st == 1 || st == 12) ? 0.5f : 1.f}; e(acc, u, wr, wc, fr, fq); }
        else if (st == 2) {
            if (li == 0) { EpiConvIn e{(bf16*)(ws + WS_M1), (bf16*)(ws + WS_M2), SSQ + (size_t)1 * MPAD, a.out + OUT_CP, a.out + OUT_CS}; e(acc, u, wr, wc, fr, fq); }
            else { EpiRecIn e{(bf16*)(ws + WS_M1), (_Float16*)(ws + WS_LOGF), (bf16*)(ws + WS_M2), (bf16*)(ws + WS_RG), SSQ + (size_t)5 * MPAD, INP(15)}; e(acc, u, wr, wc, fr, fq); } }
        else { EpiSoftmax e{(bf16*)(ws + WS_P), scr, SSQ + (size_t)(li * 4 + 2) * MPAD}; e(acc, u, wr, wc, fr, fq); }
    }
};
}
template <int NG, int MTN> __device__ __forceinline__ void skinny_acc(const bf16* Ap, const bf16* B0, const bf16* B1, int lda, int nks, f32x4 (&acc0)[8], f32x4 (&acc1)[8]) {
    constexpr int BT = (NG == 2 ? 2 : 4) * (MTN <= 4 ? 2 : 1);
#pragma unroll 1
    for (int k4 = 0; k4 < nks; k4 += BT) {
        bf16x8 b0[BT], b1[BT], av[BT][MTN];
#pragma unroll
        for (int s = 0; s < BT; ++s) { const int ks = (k4 + s < nks) ? k4 + s : nks - 1;
            b0[s] = *(const bf16x8*)(B0 + 32 * ks); if (NG == 2) b1[s] = *(const bf16x8*)(B1 + 32 * ks);
#pragma unroll
            for (int i = 0; i < MTN; ++i) av[s][i] = *(const bf16x8*)(Ap + (size_t)(16 * i) * lda + 32 * ks); }
#pragma unroll
        for (int s = 0; s < BT; ++s) if (k4 + s < nks) {
#pragma unroll
            for (int i = 0; i < MTN; ++i) { acc0[i] = mfma16(b0[s], av[s][i], acc0[i]); if (NG == 2) acc1[i] = mfma16(b1[s], av[s][i], acc1[i]); } }
    }
}
__device__ __forceinline__ void skinny_phase(LAS unsigned char* lds, const Args& a, int gs0, int G, int bx) {
    const int z = opaque0(); const int gs = gs0 + z; GemmDesc d; gemm_desc(a, gs, true, d);
    unsigned char* ws = a.ws + z; float* SSQ = (float*)(ws + WS_SSQ);
    const int li = gs >= 15 ? 1 : 0, st = gs - 2 - 13 * li;
    const int tid = otid(), lane = tid & 63, w = __builtin_amdgcn_readfirstlane(tid >> 6), r = lane & 15, q = lane >> 4;
    const bool conv = (st == 2 && li == 0);
    const int ngrp = conv ? 64 + 64 : d.N / 16;
    const int RS = ngrp <= 64 ? 4 : (ngrp <= 128 ? 2 : 1), mtn = 8 / RS, nunits = ngrp * RS;
    const int kw = d.K / 8, nks = kw / 32;
    LAS f32x4* R = (LAS f32x4*)lds;
    const int mt_e = tid >> 6;
    const int ssq_in = li * 4 + (st == 2 ? 1 : st == 7 ? 2 : 3);
#pragma unroll 1
    for (int uu = bx; uu < nunits; uu += G) {
        const int u = uu / RS, rq = uu % RS, rbase = rq * 16 * mtn;
        const int row_s = rbase + 16 * mt_e + r, grow = MP + row_s;
        const float rs = pg8::ssq_rstd(SSQ + (size_t)ssq_in * MPAD, grow);
        const bool pair = conv && u >= 64;
        int n0, n1;
        if (pair) { const int j = u - 64; n0 = D + (j >> 3) * 256 + (j & 7) * 16; n1 = n0 + 128; }
        else { n0 = 16 * u; n1 = n0; }
        f32x4 acc0[8], acc1[8];
#pragma unroll
        for (int i = 0; i < 8; ++i) { acc0[i] = (f32x4){0.f, 0.f, 0.f, 0.f}; acc1[i] = (f32x4){0.f, 0.f, 0.f, 0.f}; }
        const bf16* Ap = (const bf16*)d.A + (size_t)(MP + rbase + r) * d.lda + w * kw + 8 * q;
        const bf16* B0 = (const bf16*)d.B + (size_t)(n0 + r) * d.ldb + w * kw + 8 * q;
        const bf16* B1 = (const bf16*)d.B + (size_t)(n1 + r) * d.ldb + w * kw + 8 * q;
        if (RS == 4) skinny_acc<1, 2>(Ap, B0, B1, d.lda, nks, acc0, acc1);
        else if (RS == 2) { if (pair) skinny_acc<2, 4>(Ap, B0, B1, d.lda, nks, acc0, acc1); else skinny_acc<1, 4>(Ap, B0, B1, d.lda, nks, acc0, acc1); }
        else skinny_acc<1, 8>(Ap, B0, B1, d.lda, nks, acc0, acc1);
#pragma unroll
        for (int i = 0; i < 8; ++i) if (i < mtn) { R[(w * 8 + i) * 64 + lane] = acc0[i]; if (pair) R[4096 + (w * 8 + i) * 64 + lane] = acc1[i]; }
        __syncthreads();
        if (mt_e < mtn) {
        f32x4 v0 = R[mt_e * 64 + lane], v1 = (f32x4){0.f, 0.f, 0.f, 0.f};
#pragma unroll
        for (int k = 1; k < 8; ++k) v0 += R[(k * 8 + mt_e) * 64 + lane];
        if (pair) {
#pragma unroll
            for (int k = 0; k < 8; ++k) v1 += R[4096 + (k * 8 + mt_e) * 64 + lane]; }
        const unsigned c0 = n0 + 4 * q;
        if (st == 1 || st == 12 || st == 6 || st == 10) {
            const int so = li * 4 + (st == 1 ? 1 : st == 6 ? 2 : st == 10 ? 3 : 4); const float alpha = (st == 1 || st == 12) ? 0.5f : 1.f;
            bf16* XB = (bf16*)(ws + WS_XB); f32x4 xi;
            if (gs == 3) xi = *(const f32x4*)(INP(1) + (size_t)row_s * D + c0);
            else { const u32x2 xw = *(const u32x2*)(XB + (size_t)grow * D + c0); xi = (f32x4){bflo(xw.x), bfhi(xw.x), bflo(xw.y), bfhi(xw.y)}; }
            const f32x4 x0 = xi + v0 * alpha;
            *(u32x2*)(XB + (size_t)grow * D + c0) = pg8::pk4(x0);
            float ss = (x0[0] * x0[0] + x0[1] * x0[1]) + (x0[2] * x0[2] + x0[3] * x0[3]);
            ss += __shfl_xor(ss, 16); ss += __shfl_xor(ss, 32);
            if (q == 0) pg8::ssq_add(SSQ + (size_t)so * MPAD, grow, ss);
        } else if (conv) {
            if (!pair) { *(u32x2*)((bf16*)(ws + WS_M1) + (size_t)grow * D + c0) = pg8::pk4(v0 * rs); }
            else { const unsigned ch = (u - 64) * 16 + 4 * q; const f32x4 v = (v0 * rs) * (v1 * rs);
                *(u32x2*)((bf16*)(ws + WS_M2) + (size_t)grow * D + ch) = pg8::pk4(v); *(f32x4*)(a.out + OUT_CS + ((size_t)row_s * 2 + 1) * D + ch) = v; }
        } else if (st == 2) {
            const int part = n0 >> 10; const unsigned ch0 = (n0 & 1023) + 4 * q;
            f32x4 y0 = v0 * rs;
            if (part == 1) { const float* lbr = INP(15); f32x4 o0;
#pragma unroll
                for (int e = 0; e < 4; ++e) { const float lb0 = __builtin_amdgcn_rcpf(1.f + __expf(lbr[ch0 + e] - lbr[D + ch0 + e]));
                    o0[e] = lb0 + (1.f - lb0) * __builtin_amdgcn_rcpf(1.f + __expf(-y0[e])); }
                *(f16x4*)((_Float16*)(ws + WS_LOGF) + (size_t)grow * D + ch0) = __builtin_convertvector(o0, f16x4);
            } else { if (part != 2) {
#pragma unroll
                    for (int e = 0; e < 4; ++e) y0[e] = silu_f(y0[e]); }
                bf16* dst = (bf16*)(ws + (part == 0 ? WS_M1 : part == 2 ? WS_M2 : WS_RG));
                *(u32x2*)(dst + (size_t)grow * D + ch0) = pg8::pk4(y0); }
        } else {
            *(u32x2*)((bf16*)(ws + WS_Q) + (size_t)grow * D + c0) = pg8::pk4(v0 * (rs * QSCALE));
        }
        }
        __syncthreads();
    }
}

__global__ void __launch_bounds__(NTHR, 2) mega_fwd(Args a) {
    extern __shared__ __attribute__((aligned(16))) unsigned char lds_raw[];
    LAS unsigned char* lds = (LAS unsigned char*)lds_raw;
    const int tid = otid(), G = gridDim.x, bx = blockIdx.x;
    const int vcu = (G % 8 == 0) ? (bx % 8) * (G / 8) + bx / 8 : bx;
    volatile LAS unsigned* misc = (volatile LAS unsigned*)(lds + LDS_MISC);
    if (tid < 64) misc[tid] = 0u;
    __syncthreads();
    XcdBarrier bar = xcd_barrier_post((unsigned*)(a.ws + WS_CTL) + 1024, misc + 8);
    const int lo = a.ph_lo, hi = a.ph_hi;
#pragma unroll 1
    for (int gs = lo; gs < hi; ++gs) {
        const int z = opaque0(); unsigned char* ws = a.ws + z;
        const int li = gs >= 15 ? 1 : 0, st = gs - 2 - 13 * li;
        const bool layer_step = gs >= 2 && gs < 28;
        if (gs == 1 || (layer_step && ((li == 0 && (st == 4 || st == 5)) || st == 9))) continue;
        const int nrep = (gs == REP_GS) ? 1 + REP_N : 1;
#define PART(p) (rep == 0 || (REP_PARTS & (p)))
#pragma unroll 1
        for (int rep = 0; rep < nrep; ++rep) {
        if (gs == 0) { if (DM(0)) prologue(a, z, lds, vcu, G);
        } else if (gs == 28) {
            if (DM(13)) {
            const float* ssq = (const float*)(ws + WS_SSQ) + (size_t)8 * MPAD; const float* gf = INP(28); const bf16* XBf = (const bf16*)(ws + WS_XB);
            const int nth = G * NTHR, gt = vcu * NTHR + otid();
            if ((nth & 127) == 0) {
                const int c4 = (gt & 127) * 8; const f32x4 g0 = *(const f32x4*)(gf + c4), g1 = *(const f32x4*)(gf + c4 + 4);
#pragma unroll 1
                for (int it0 = gt; it0 < MT * 128; it0 += 4 * nth) { u32x4 xw[4]; float r[4];
#pragma unroll
                    for (int j = 0; j < 4; ++j) { const int it = it0 + j * nth; const int row = it < MT * 128 ? (it >> 7) : 0; xw[j] = *(const u32x4*)(XBf + (size_t)row * D + c4); r[j] = pg8::ssq_rstd(ssq, row); }
#pragma unroll
                    for (int j = 0; j < 4; ++j) { const int it = it0 + j * nth; if (it < MT * 128) { const int row = it >> 7;
                        const f32x4 v0 = (f32x4){bflo(xw[j].x), bfhi(xw[j].x), bflo(xw[j].y), bfhi(xw[j].y)} * r[j] * g0, v1 = (f32x4){bflo(xw[j].z), bfhi(xw[j].z), bflo(xw[j].w), bfhi(xw[j].w)} * r[j] * g1;
                        float* dst = row < MP ? a.out + OUT_YP + (size_t)row * D + c4 : a.out + OUT_YS + (size_t)(row - MP) * D + c4;
                        *(f32x4*)dst = v0; *((f32x4*)dst + 1) = v1; } } }
            } else {
            for (int it = gt; it < MT * 128; it += nth) { const int row = it >> 7, c4 = (it & 127) * 8;
                const float r = pg8::ssq_rstd(ssq, row); const u32x4 xw = *(const u32x4*)(XBf + (size_t)row * D + c4);
                const f32x4 v0 = (f32x4){bflo(xw.x), bfhi(xw.x), bflo(xw.y), bfhi(xw.y)} * r * *(const f32x4*)(gf + c4), v1 = (f32x4){bflo(xw.z), bfhi(xw.z), bflo(xw.w), bfhi(xw.w)} * r * *(const f32x4*)(gf + c4 + 4);
                float* dst = row < MP ? a.out + OUT_YP + (size_t)row * D + c4 : a.out + OUT_YS + (size_t)(row - MP) * D + c4;
                *(f32x4*)dst = v0; *((f32x4*)dst + 1) = v1; } } }
        } else if (layer_step && st == 3) {
            if (li == 0) { if (DM(6)) conv_phase(a, z, vcu, G); }
            else if (DM(7)) {
                   gla_g1_phase(lds, ws, bx, G);
#pragma unroll 1
                   for (int u = bx; u < NS * 8; u += G) sample_rec_unit(lds, a, z, u >> 3, u & 7); }
        } else if (layer_step && st == 4) { if (DM(8)) gla_g2(a, z, vcu, G);
        } else if (layer_step && st == 5) { if (DM(9)) {
            gla_g3_phase(lds, a, z, bx, G); }
        } else {
            if (DM(1) && PART(1) && st != 10) { GemmDesc d; gemm_desc(a, gs + z, false, d);
                pg8::SchedAny S{a, gs, G, bx}; pg8::EpiAny E{a, gs, (LAS float*)(lds + LDS_SCR)};
                pg8::gemm_phase(lds, d.K, d.lda, d.ldb, S, E); }
            if (layer_step && st != 8 && st != 0 && st != 11 && DM(14) && PART(2)) { __syncthreads(); skinny_phase(lds, a, gs, G, (bx + 128) % G); }
            if (st == 8 && DM(11) && PART(4)) {
                __syncthreads();
#pragma unroll 1
                for (int u = bx; u < NS * 2; u += G) sample_attn_unit(lds, INP(5) + (size_t)li * NS * NMEM * D, INP(6) + (size_t)li * NS * NMEM * D, (const bf16*)(ws + WS_Q), (bf16*)(ws + WS_O), u >> 1, u & 1);
            }
        }
        if (rep + 1 < nrep) xcd_barrier(bar);
        }
        if (gs + 1 < hi) { if (hi > 4096) cg::this_grid().sync();   xcd_barrier(bar); }
    }
}

extern "C" void kernel_launch(void* const* d_in, const int* in_sizes, int n_in, void* d_out, int out_size, void* d_ws, size_t ws_size, hipStream_t stream) {
    static int grid = 0;
    if (grid == 0) {
        if (n_in != 29 || ws_size < WS_END) { fprintf(stderr, "kernel_launch: unexpected n_in %d / ws %zu (need %zu)\n", n_in, ws_size, (size_t)WS_END); grid = -1; return; }
        int dev = 0, cus = 0, per_cu = 0;
        hipGetDevice(&dev); hipDeviceGetAttribute(&cus, hipDeviceAttributeMultiprocessorCount, dev);
        if (hipFuncSetAttribute((const void*)mega_fwd, hipFuncAttributeMaxDynamicSharedMemorySize, LDS_BYTES) != hipSuccess) { fprintf(stderr, "kernel_launch: hipFuncSetAttribute failed\n"); grid = -1; return; }
        hipOccupancyMaxActiveBlocksPerMultiprocessor(&per_cu, (const void*)mega_fwd, NTHR, LDS_BYTES);
        (void)hipGetLastError();
        if (per_cu < 1) fprintf(stderr, "kernel_launch: occupancy query says %d\n", per_cu);
        grid = cus;
    }
    if (grid < 0) return;
    hipMemsetAsync((char*)d_ws + WS_CTL, 0, CTL_BYTES, stream);
    Args a{};
    for (int i = 0; i < 29; ++i) a.in[i] = (const float*)d_in[i];
    a.out = (float*)d_out; a.ws = (unsigned char*)d_ws; a.ph_lo = 0; a.ph_hi = NSTEPS;
    void* args[] = {&a};
    hipError_t e = hipLaunchCooperativeKernel((const void*)mega_fwd, dim3(grid), dim3(NTHR), args, LDS_BYTES, stream);
    if (e != hipSuccess) fprintf(stderr, "cooperative launch failed: %s (grid %d)\n", hipGetErrorString(e), grid);
}
```

```cpp
#include <hip/hip_runtime.h>
#include <hip/hip_cooperative_groups.h>
#include <cstdio>
#include <cstdint>
namespace cg = cooperative_groups;

#ifndef DBG_MASK
#define DBG_MASK 0xFFFFF
#endif
#define DM(b) ((DBG_MASK >> (b)) & 1)
#ifndef REP_GS
#define REP_GS -1
#endif
#ifndef REP_N
#define REP_N 0
#endif
#ifndef REP_PARTS
#define REP_PARTS 7
#endif
#define LAS __attribute__((address_space(3)))
typedef unsigned short bf16;
typedef short bf16x8 __attribute__((ext_vector_type(8)));
typedef float f32x4 __attribute__((ext_vector_type(4)));
typedef float f32x2 __attribute__((ext_vector_type(2)));
typedef unsigned u32x4 __attribute__((ext_vector_type(4)));
typedef unsigned u32x2 __attribute__((ext_vector_type(2)));

constexpr int D = 1024, NB = 8, T = 2048, MP = NB * T, NS = 128, MT = MP + NS, MPAD = 16640, FF = 2816;
constexpr int NMEM = 256, MEMR = NB * NMEM;
constexpr float EPS = 1e-6f;
constexpr float QSCALE = 0.0625f * 1.4426950408889634f;
constexpr int NTHR = 512, NWAVES = 8;

constexpr size_t al256(size_t x) { return (x + 255) & ~(size_t)255; }
constexpr size_t WS_CTL = 0, CTL_BYTES = 65536;
constexpr size_t WS_SSQ = CTL_BYTES;
constexpr size_t WS_MSSQ = WS_SSQ + al256((size_t)9 * MPAD * 4);
constexpr size_t WS_WGU = WS_MSSQ + al256(MEMR * 4);
constexpr size_t SZ_WGU = (size_t)2 * FF * D * 2;
constexpr size_t WS_WD = WS_WGU + 4 * SZ_WGU;
constexpr size_t SZ_WD = (size_t)D * FF * 2;
constexpr size_t WS_WQ = WS_WD + 4 * SZ_WD;
constexpr size_t SZ_DD = (size_t)D * D * 2;
constexpr size_t WS_WKV = WS_WQ + 2 * SZ_DD;
constexpr size_t WS_WO = WS_WKV + 4 * SZ_DD;
constexpr size_t WS_WMO = WS_WO + 2 * SZ_DD;
constexpr size_t WS_WCI = WS_WMO + 2 * SZ_DD;
constexpr size_t WS_WRI = WS_WCI + 3 * SZ_DD;
constexpr size_t WS_X = WS_WRI + 4 * SZ_DD;
constexpr size_t SZ_ACT2 = (size_t)MPAD * D * 2, SZ_ACT4 = (size_t)MPAD * D * 4;
constexpr size_t WS_XB = WS_X + SZ_ACT4;
constexpr size_t WS_H = WS_XB + SZ_ACT2;
constexpr size_t WS_MEMB = WS_H + (size_t)MPAD * FF * 2;
constexpr size_t WS_MEMK = WS_MEMB + (size_t)MEMR * D * 2;
constexpr size_t WS_VT = WS_MEMK + 2 * (size_t)MEMR * D * 2;
constexpr size_t WS_Q = WS_VT + 2 * (size_t)MEMR * D * 2;
constexpr size_t WS_P = WS_Q + SZ_ACT2;
constexpr size_t WS_O = WS_P + SZ_ACT2;
constexpr size_t WS_M1 = WS_O + SZ_ACT2;
constexpr size_t WS_M2 = WS_M1 + SZ_ACT2;
constexpr size_t WS_RG = WS_M2 + SZ_ACT2;
constexpr size_t WS_LOGF = WS_RG + SZ_ACT2;
constexpr size_t WS_G = WS_LOGF + SZ_ACT4;
constexpr size_t WS_QBG = WS_G + SZ_ACT2;
constexpr size_t WS_OINTRA = WS_QBG + (size_t)MP * D * 2;
constexpr size_t WS_UT = WS_OINTRA + (size_t)MP * D * 4;
constexpr size_t WS_SPT = WS_UT + (size_t)2048 * 16384 * 4;
constexpr size_t WS_DEC = WS_SPT + (size_t)2048 * 16384 * 2;
constexpr size_t WS_WQN = WS_DEC + (size_t)2048 * 128 * 4;
constexpr size_t WS_WQK = WS_WQN + 2 * SZ_DD;
constexpr size_t WS_VWT = WS_WQK + 2 * 8 * SZ_DD;
constexpr size_t WS_END = WS_VWT + 2 * 8 * SZ_DD;
static_assert(WS_END <= (size_t)1023 * 1024 * 1024, "workspace map too large");

constexpr size_t OUT_YP = 0, OUT_YS = (size_t)MP * D, OUT_MK = OUT_YS + (size_t)NS * D, OUT_MV = OUT_MK + (size_t)2 * MEMR * D,
                 OUT_CP = OUT_MV + (size_t)2 * MEMR * D, OUT_RP = OUT_CP + (size_t)NB * 2 * D, OUT_CS = OUT_RP + (size_t)NB * 8 * 16384,
                 OUT_RS = OUT_CS + (size_t)NS * 2 * D;

constexpr int LDS_STAGE = 131072, LDS_SCR = 131072, LDS_MISC = LDS_SCR + 12288, LDS_BYTES = 147456;

__device__ __forceinline__ unsigned f2bf(float f) { unsigned u = __builtin_bit_cast(unsigned, f); return (u + 0x7fffu + ((u >> 16) & 1u)) >> 16; }
typedef __bf16 bf16x2_t __attribute__((ext_vector_type(2)));
typedef _Float16 f16x4 __attribute__((ext_vector_type(4)));
__device__ __forceinline__ unsigned pk2(float lo, float hi) { const f32x2 v = {lo, hi}; const bf16x2_t b = __builtin_convertvector(v, bf16x2_t); return __builtin_bit_cast(unsigned, b); }
__device__ __forceinline__ float bf2f(unsigned b) { return __builtin_bit_cast(float, b << 16); }
__device__ __forceinline__ float bflo(unsigned w) { return __builtin_bit_cast(float, w << 16); }
__device__ __forceinline__ float bfhi(unsigned w) { return __builtin_bit_cast(float, w & 0xffff0000u); }
__device__ __forceinline__ float wave_sum(float v) {
#pragma unroll
    for (int o = 1; o < 64; o <<= 1) v += __shfl_xor(v, o);
    return v;
}
__device__ __forceinline__ float wave_max(float v) {
#pragma unroll
    for (int o = 1; o < 64; o <<= 1) v = fmaxf(v, __shfl_xor(v, o));
    return v;
}
__device__ __forceinline__ int otid() { int t; asm volatile("v_mov_b32 %0, %1" : "=v"(t) : "v"((int)threadIdx.x)); return t; }
__device__ __forceinline__ float silu_f(float g) { return g * __builtin_amdgcn_rcpf(1.f + __expf(-g)); }
#define LDS_WAIT() asm volatile("s_waitcnt lgkmcnt(0)" ::: "memory")

#define XB_TMO      128
#define XB_XCNT(j)  (256  + 64 * (j))
#define XB_XSUB(j)  (1280 + 64 * (j))
#define XB_XGEN(j)  (2304 + 64 * (j))
#define XB_TOP      3328
#define XB_TOPGEN   3392
#define XCD_BAR_WORDS 3456
#define XB_SPIN_CAP (1u << 22)
__device__ __forceinline__ unsigned xb_ld(unsigned* p)              { return __hip_atomic_load(p, __ATOMIC_RELAXED, __HIP_MEMORY_SCOPE_AGENT); }
__device__ __forceinline__ unsigned xb_add(unsigned* p, unsigned v) { return __hip_atomic_fetch_add(p, v, __ATOMIC_RELAXED, __HIP_MEMORY_SCOPE_AGENT); }
__device__ __forceinline__ unsigned xb_xcc_id() { return (unsigned)__builtin_amdgcn_s_getreg((3 << 11) | 20) & 0xFu; }
#define XB_SPIN(cond, bar) do { unsigned _sp = 0; while (cond) { __builtin_amdgcn_s_sleep(1); \
    if ((++_sp & 255u) == 0u) { if (xb_ld(&(bar)[XB_TMO])) break; if (_sp > XB_SPIN_CAP) { atomicAdd(&(bar)[XB_TMO], 1u); break; } } } } while (0)
struct XcdBarrier { unsigned* bar; unsigned x; volatile LAS unsigned* st; };
__device__ __forceinline__ XcdBarrier xcd_barrier_post(unsigned* bar, volatile LAS unsigned* st) {
    XcdBarrier b; b.bar = bar; b.x = xb_xcc_id(); b.st = st;
    if (threadIdx.x == 0) (void)xb_add(&bar[XB_XCNT(b.x)], 1u);
    return b;
}
__device__ __forceinline__ void xcd_barrier_complete(unsigned* bar, unsigned x, unsigned& nloc, unsigned& nx) {
    const unsigned G = gridDim.x * gridDim.y * gridDim.z;
    unsigned sum, cnt, mine, sp = 0u;
    for (;;) {
        sum = 0u; cnt = 0u; mine = 0u;
#pragma unroll
        for (unsigned j = 0; j < 16; ++j) { const unsigned c = xb_ld(&bar[XB_XCNT(j)]); sum += c; cnt += (c > 0u) ? 1u : 0u; mine = (j == x) ? c : mine; }
        if (sum == G) break;
        __builtin_amdgcn_s_sleep(1);
        if ((++sp & 255u) == 0u) { if (xb_ld(&bar[XB_TMO])) break; if (sp > XB_SPIN_CAP) { atomicAdd(&bar[XB_TMO], 1u); break; } }
    }
    nloc = mine > 0u ? mine : 1u; nx = cnt > 0u ? cnt : 1u;
}
__device__ __forceinline__ void xcd_barrier(const XcdBarrier& b) {
    asm volatile("s_waitcnt vmcnt(0)" ::: "memory");
    __syncthreads();
    if (threadIdx.x == 0) {
        unsigned* bar = b.bar;
        __builtin_amdgcn_s_waitcnt(0);
        unsigned nloc = b.st[0], nx = b.st[1];
        if (nloc == 0u) { xcd_barrier_complete(bar, b.x, nloc, nx); b.st[0] = nloc; b.st[1] = nx; }
        const unsigned old = xb_add(&bar[XB_XSUB(b.x)], 1u);
        const unsigned gen = old / nloc;
        if (old + 1u == (gen + 1u) * nloc) {
            __builtin_amdgcn_fence(__ATOMIC_RELEASE, "agent");
            asm volatile("s_waitcnt vmcnt(0)" ::: "memory");
            const unsigned og = xb_add(&bar[XB_TOP], 1u);
            const unsigned tg = og / nx;
            if (og + 1u == (tg + 1u) * nx) xb_add(&bar[XB_TOPGEN], 1u);
            else XB_SPIN(xb_ld(&bar[XB_TOPGEN]) == tg, bar);
            __builtin_amdgcn_fence(__ATOMIC_ACQUIRE, "agent");
            xb_add(&bar[XB_XGEN(b.x)], 1u);
            asm volatile("s_waitcnt vmcnt(0)" ::: "memory");
        } else {
            XB_SPIN(xb_ld(&bar[XB_XGEN(b.x)]) == gen, bar);
            __builtin_amdgcn_fence(__ATOMIC_ACQUIRE, "agent");
            asm volatile("s_waitcnt vmcnt(0)" ::: "memory");
        }
    }
    __syncthreads();
}

namespace pg8 {
constexpr int BM = 256, BK = 64, HALF = 128, HTB = HALF * BK * 2, STAGE_BYTES = 8 * HTB, NXCD = 8, WGM = 8;
__device__ __forceinline__ int lds_byte(int r, int c) { const int st = (r >> 4) * 2 + (c >> 5), rr = r & 15, cc = c & 31, ob = rr * 64 + cc * 2; return st * 1024 + (ob ^ (((ob >> 9) & 1) << 5)); }
__device__ __forceinline__ void stage_rc(int b, int& R, int& C) { const int st = b / 1024, sb = b % 1024, swz = sb ^ (((sb >> 9) & 1) << 5); R = (st >> 1) * 16 + swz / 64; C = (st & 1) * 32 + (swz % 64) / 2; }

struct Unit { const char* A; const char* B; int row0, col0, nt, kind; };

typedef f32x4 Acc[2][2][4][2];

template <class Epi, class Sched>
__device__ __forceinline__ void gemm_phase(LAS unsigned char* lds, int K, int lda, int ldb, const Sched& S, const Epi& E) {
    const int tid = otid(), wid = __builtin_amdgcn_readfirstlane(tid >> 6), lane = tid & 63, wr = wid >> 2, wc = wid & 3, fr = lane & 15, fq = lane >> 4;
    unsigned voffA[2], voffB[2];
#pragma unroll
    for (int i = 0; i < 2; ++i) { int R, C; stage_rc(tid * 16 + i * 8192, R, C); const int rho = R & 31, Rb = (R & ~31) + 8 * ((rho & 15) >> 2) + 4 * (rho >> 4) + (rho & 3);
        voffA[i] = (unsigned)(R * lda + C) * 2u; voffB[i] = (unsigned)(Rb * ldb + C) * 2u; }
    const size_t kstep = (size_t)(BK * 2);
    const size_t hstepA = (size_t)HALF * lda * 2, hstepB = (size_t)HALF * ldb * 2;
    const unsigned ldsw = (unsigned)wid * 1024u;
    const int aoff = lds_byte(wr * 64 + fr, fq * 8), boff = lds_byte(wc * 32 + fr, fq * 8);
#define PG8_SA(b, h) (((b) * 2 + (h)) * HTB)
#define PG8_SB(b, h) ((4 + (b) * 2 + (h)) * HTB)
#define PG8_STAGE(bufoff, gbase, voff) do { _Pragma("unroll") for (int _i = 0; _i < 2; ++_i) \
        __builtin_amdgcn_global_load_lds((const unsigned*)((const char*)(gbase) + (voff)[_i]), (LAS unsigned*)(lds + (bufoff) + ldsw + _i * 8192), 16, 0, 0); } while (0)
#define PG8_LDA(dst, b, h) do { _Pragma("unroll") for (int m = 0; m < 4; ++m) _Pragma("unroll") for (int k = 0; k < 2; ++k) dst[m][k] = *(const LAS bf16x8*)(lds + PG8_SA(b, h) + aoff + m * 2048 + k * 1024); } while (0)
#define PG8_LDB(dst, b, h) do { _Pragma("unroll") for (int n = 0; n < 2; ++n) _Pragma("unroll") for (int k = 0; k < 2; ++k) dst[n][k] = *(const LAS bf16x8*)(lds + PG8_SB(b, h) + boff + n * 2048 + k * 1024); } while (0)
#define PG8_MMA(ai, bj, At, Bt) do { __builtin_amdgcn_s_setprio(1); _Pragma("unroll") for (int m = 0; m < 4; ++m) _Pragma("unroll") for (int n = 0; n < 2; ++n) _Pragma("unroll") for (int k = 0; k < 2; ++k) \
        acc[ai][bj][m][n] = __builtin_amdgcn_mfma_f32_16x16x32_bf16(Bt[n][k], At[m][k], acc[ai][bj][m][n], 0, 0, 0); __builtin_amdgcn_s_setprio(0); } while (0)
#define PG8_WAIT_V(n) asm volatile("s_waitcnt vmcnt(" #n ")" ::: "memory")
#define PG8_WAIT_L(n) asm volatile("s_waitcnt lgkmcnt(" #n ")" ::: "memory")
#define PG8_BAR __builtin_amdgcn_s_barrier()
#define PG8_SCHED __builtin_amdgcn_sched_barrier(0)
    Unit cur, nxt; int ui = 0;
    if (!S.next(0, cur)) return;
    Acc acc;
#pragma unroll
    for (int a = 0; a < 2; ++a)
#pragma unroll
        for (int b = 0; b < 2; ++b)
#pragma unroll
            for (int m = 0; m < 4; ++m)
#pragma unroll
                for (int n = 0; n < 2; ++n) acc[a][b][m][n] = (f32x4){0.f, 0.f, 0.f, 0.f};
    bf16x8 At[4][2], B0[2][2], B1[2][2];
    const char* cA = cur.A; const char* cB = cur.B;
    PG8_STAGE(PG8_SB(0, 0), cB, voffB); PG8_STAGE(PG8_SB(0, 1), cB + hstepB, voffB); PG8_STAGE(PG8_SA(0, 0), cA, voffA); PG8_STAGE(PG8_SA(0, 1), cA + hstepA, voffA);
    if (wr == 1) PG8_BAR;
    PG8_WAIT_V(2); PG8_BAR;
    PG8_STAGE(PG8_SB(1, 0), cB + kstep, voffB); PG8_STAGE(PG8_SA(1, 0), cA + kstep, voffA); PG8_STAGE(PG8_SB(1, 1), cB + hstepB + kstep, voffB);
    PG8_WAIT_V(6); PG8_BAR;
    for (;;) {
        const bool has_next = S.next(ui + 1, nxt);
        const char* nA = has_next ? nxt.A : cA; const char* nB = has_next ? nxt.B : cB;
#pragma unroll 1
        for (int t = 0; t < cur.nt; t += 2) {
            const bool last = (t == cur.nt - 2);
            const char* a1 = cA + (size_t)(t + 1) * kstep;
            const char* a2 = last ? nA : cA + (size_t)(t + 2) * kstep; const char* b2 = last ? nB : cB + (size_t)(t + 2) * kstep;
            const char* a3 = a2 + kstep; const char* b3 = b2 + kstep;
            PG8_LDB(B0, 0, 0); PG8_LDB(B1, 0, 1); PG8_SCHED; PG8_LDA(At, 0, 0); PG8_STAGE(PG8_SA(1, 1), a1 + hstepA, voffA);
            PG8_WAIT_V(8); PG8_WAIT_L(0); PG8_BAR; PG8_MMA(0, 0, At, B0); PG8_MMA(0, 1, At, B1); PG8_BAR; PG8_SCHED;
            PG8_LDA(At, 0, 1); PG8_STAGE(PG8_SB(0, 0), b2, voffB); PG8_STAGE(PG8_SB(0, 1), b2 + hstepB, voffB); PG8_STAGE(PG8_SA(0, 0), a2, voffA);
            PG8_WAIT_V(8); PG8_WAIT_L(0); PG8_BAR; PG8_MMA(1, 0, At, B0); PG8_MMA(1, 1, At, B1); PG8_BAR; PG8_SCHED;
            PG8_LDB(B0, 1, 0); PG8_LDB(B1, 1, 1); PG8_SCHED; PG8_LDA(At, 1, 0); PG8_STAGE(PG8_SA(0, 1), a2 + hstepA, voffA);
            PG8_WAIT_V(8); PG8_WAIT_L(0); PG8_BAR; PG8_MMA(0, 0, At, B0); PG8_MMA(0, 1, At, B1); PG8_BAR; PG8_SCHED;
            PG8_LDA(At, 1, 1); PG8_STAGE(PG8_SB(1, 0), b3, voffB); PG8_STAGE(PG8_SB(1, 1), b3 + hstepB, voffB); PG8_STAGE(PG8_SA(1, 0), a3, voffA);
            PG8_WAIT_V(8); PG8_WAIT_L(0); PG8_BAR; PG8_MMA(1, 0, At, B0); PG8_MMA(1, 1, At, B1); PG8_BAR; PG8_SCHED;
        }
        if (wr == 0) PG8_BAR;
        E(acc, cur, wr, wc, fr, fq);
        if (!has_next) break;
#pragma unroll
        for (int a = 0; a < 2; ++a)
#pragma unroll
            for (int b = 0; b < 2; ++b)
#pragma unroll
                for (int m = 0; m < 4; ++m)
#pragma unroll
                    for (int n = 0; n < 2; ++n) acc[a][b][m][n] = (f32x4){0.f, 0.f, 0.f, 0.f};
        cur = nxt; cA = nA; cB = nB; ++ui;
        if (wr == 1) PG8_BAR;
    }
    PG8_WAIT_V(0);
    PG8_BAR;
#undef PG8_SA
#undef PG8_SB
#undef PG8_STAGE
#undef PG8_LDA
#undef PG8_LDB
#undef PG8_MMA
}

struct Sched2D {
    const char* A; const char* B; int lda, ldb, nM, nN, nwg, G, c; size_t bstride;
    __device__ __forceinline__ void init(const bf16* A_, int lda_, const bf16* B_, int ldb_, int M, int N, int G_, int c_) {
        A = (const char*)A_; B = (const char*)B_; bstride = 0; lda = lda_; ldb = ldb_; nM = M / BM; nN = N / BM; nwg = nM * nN; G = G_; c = c_; }
    __device__ __forceinline__ bool next(int i, Unit& u) const {
        const long L = (long)i * G + c; if (L >= nwg) return false;
        int wgid = (int)L; { const int q = nwg / NXCD, r = nwg % NXCD, xcd = wgid % NXCD, off = wgid / NXCD; wgid = (xcd < r ? xcd * (q + 1) : r * (q + 1) + (xcd - r) * q) + off; }
        const int nig = WGM * nN, gid = wgid / nig, fm = gid * WGM, gsz = (nM - fm) < WGM ? (nM - fm) : WGM;
        const int pm = fm + ((wgid % nig) % gsz), pn = (wgid % nig) / gsz;
        u.A = A + (size_t)pm * BM * lda * 2; u.B = B + (size_t)(pm >> 3) * bstride + (size_t)pn * BM * ldb * 2; u.row0 = pm * BM; u.col0 = pn * BM; return true;
    }
};
struct SchedAttn {
    const char* A; const char* B; int mode, G, c;
    __device__ __forceinline__ bool next(int i, Unit& u) const {
        const int L = i * G + c; if (L >= 256) return false;
        const int wgid = (L % NXCD) * 32 + L / NXCD;
        const int bh = wgid >> 3, qt = wgid & 7, b = bh >> 2, h = bh & 3;
        u.row0 = b * T + qt * 256; u.col0 = h * 256;
        u.A = A + ((size_t)u.row0 * D + h * 256) * 2;
        u.B = mode == 0 ? B + ((size_t)(b * NMEM) * D + h * 256) * 2 : B + ((size_t)(h * 256) * MEMR + b * NMEM) * 2;
        return true;
    }
};

constexpr float SSQ_FX = 1024.f;
__device__ __forceinline__ float ssq_rstd(const float* ssq, unsigned row) { return rsqrtf((float)*(const unsigned*)((const char*)ssq + row * 4u) * (1.f / (SSQ_FX * D)) + EPS); }
__device__ __forceinline__ void ssq_add(float* ssq, unsigned row, float ss) { atomicAdd((unsigned*)ssq + row, (unsigned)(ss * SSQ_FX + 0.5f)); }
#define EPI_ARGS const Acc& acc, const Unit& u, int wr, int wc, int fr, int fq
#define FOR_AM _Pragma("unroll") for (int ai = 0; ai < 2; ++ai) _Pragma("unroll") for (int m = 0; m < 4; ++m)
#define FOR_BN _Pragma("unroll") for (int bj = 0; bj < 2; ++bj) _Pragma("unroll") for (int n = 0; n < 2; ++n)
#define LOAD_RSTD(rr, ssqp, rbase) float rr[2][4]; FOR_AM rr[ai][m] = ssq_rstd(ssqp, (rbase) + ai * 128 + m * 16)
#define EPI_FENCE() do { asm volatile("" ::: "memory"); __builtin_amdgcn_sched_barrier(0); } while (0)
template <class Tp> __device__ __forceinline__ Tp& at(void* base, unsigned byteoff) { return *(Tp*)((char*)base + byteoff); }
template <class Tp> __device__ __forceinline__ const Tp& atc(const void* base, unsigned byteoff) { return *(const Tp*)((const char*)base + byteoff); }
__device__ __forceinline__ u32x2 pk4(const f32x4 v) { u32x2 w; w.x = pk2(v[0], v[1]); w.y = pk2(v[2], v[3]); return w; }
__device__ __forceinline__ u32x4 pk8(const f32x4 v0, const f32x4 v1) { u32x4 w; w.x = pk2(v0[0], v0[1]); w.y = pk2(v0[2], v0[3]); w.z = pk2(v1[0], v1[1]); w.w = pk2(v1[2], v1[3]); return w; }
#define FOR_BJ _Pragma("unroll") for (int bj = 0; bj < 2; ++bj)

struct EpiGU { bf16* H; const float* ssq;
    __device__ __forceinline__ void operator()(EPI_ARGS) const {
        const unsigned hcol = (u.col0 >> 1) + wc * 32 + 8 * fq; const unsigned rb = u.row0 + wr * 64 + fr;
        LOAD_RSTD(rr, ssq, rb);
        FOR_AM { const unsigned row = rb + ai * 128 + m * 16; const float r = rr[ai][m];
            f32x4 hv[2];
#pragma unroll
            for (int n = 0; n < 2; ++n) { const f32x4 g = acc[ai][0][m][n] * r, up = acc[ai][1][m][n] * r;
                const float d0 = 1.f + __expf(-fmaxf(g[0], -30.f)), d1 = 1.f + __expf(-fmaxf(g[1], -30.f)), d2 = 1.f + __expf(-fmaxf(g[2], -30.f)), d3 = 1.f + __expf(-fmaxf(g[3], -30.f));
                const float r01 = __builtin_amdgcn_rcpf(d0 * d1), r23 = __builtin_amdgcn_rcpf(d2 * d3);
                hv[n] = (f32x4){g[0] * up[0] * (r01 * d1), g[1] * up[1] * (r01 * d0), g[2] * up[2] * (r23 * d3), g[3] * up[3] * (r23 * d2)}; }
            at<u32x4>(H, (row * FF + hcol) * 2u) = pk8(hv[0], hv[1]);
            EPI_FENCE(); }
    }
};
struct EpiRes { const float* Xin; bf16* XB; float* ssq_out; float alpha;
    __device__ __forceinline__ void operator()(EPI_ARGS) const {
        const unsigned rb = u.row0 + wr * 64 + fr, cb = u.col0 + wc * 32 + 8 * fq;
#pragma unroll
        for (int ai = 0; ai < 2; ++ai) {
            u32x4 xpre[4][2];
            if (!Xin) {
#pragma unroll
                for (int m = 0; m < 4; ++m) { FOR_BJ { xpre[m][bj] = atc<u32x4>(XB, ((rb + ai * 128 + m * 16) * D + cb + bj * 128) * 2u); } } }
#pragma unroll
            for (int m = 0; m < 4; ++m) { const unsigned row = rb + ai * 128 + m * 16; float ss = 0.f;
                FOR_BJ { const unsigned off = row * D + cb + bj * 128; f32x4 x0, x1;
                    if (Xin) { x0 = atc<f32x4>(Xin, off * 4u); x1 = atc<f32x4>(Xin, off * 4u + 16u); }
                    else { const u32x4 xw = xpre[m][bj]; x0 = (f32x4){bflo(xw.x), bfhi(xw.x), bflo(xw.y), bfhi(xw.y)}; x1 = (f32x4){bflo(xw.z), bfhi(xw.z), bflo(xw.w), bfhi(xw.w)}; }
                    const f32x4 v0 = x0 + acc[ai][bj][m][0] * alpha, v1 = x1 + acc[ai][bj][m][1] * alpha;
                    ss += ((v0[0] * v0[0] + v0[1] * v0[1]) + (v0[2] * v0[2] + v0[3] * v0[3])) + ((v1[0] * v1[0] + v1[1] * v1[1]) + (v1[2] * v1[2] + v1[3] * v1[3]));
                    at<u32x4>(XB, off * 2u) = pk8(v0, v1); }
                ss += __shfl_xor(ss, 16); ss += __shfl_xor(ss, 32);
                if (fq == 0) ssq_add(ssq_out, row, ss);
                EPI_FENCE(); }
        }
    }
};
struct EpiConvIn { bf16* CB; bf16* CV; const float* ssq; float* out_cp; float* out_cs;
    __device__ __forceinline__ void operator()(EPI_ARGS) const {
        const int pn = u.col0 >> 8; const unsigned rb = u.row0 + wr * 64 + fr;
        LOAD_RSTD(rr, ssq, rb);
        if (pn < 4) {
            const unsigned cb = u.col0 + wc * 32 + 8 * fq;
            FOR_AM { const unsigned row = rb + ai * 128 + m * 16; const float r = rr[ai][m];
                FOR_BJ { at<u32x4>(CB, (row * D + cb + bj * 128) * 2u) = pk8(acc[ai][bj][m][0] * r, acc[ai][bj][m][1] * r); }
                EPI_FENCE(); }
        } else {
            const unsigned cb = (pn - 4) * 128 + wc * 32 + 8 * fq;
            FOR_AM { const unsigned row = rb + ai * 128 + m * 16; const float r = rr[ai][m];
#pragma unroll
                for (int n = 0; n < 2; ++n) { const unsigned ch = cb + n * 4; const f32x4 v = (acc[ai][0][m][n] * r) * (acc[ai][1][m][n] * r);
                    at<u32x2>(CV, (row * D + ch) * 2u) = pk4(v);
                    if (row < (unsigned)MP) { const unsigned t = row & (T - 1); if (t >= (unsigned)(T - 2)) at<f32x4>(out_cp, (((row >> 11) * 2 + (t - (T - 2))) * D + ch) * 4u) = v; }
                    else if (row < (unsigned)MT) at<f32x4>(out_cs, (((row - MP) * 2 + 1) * D + ch) * 4u) = v; }
                EPI_FENCE(); }
        }
    }
};
struct EpiRecIn { bf16* RQ; _Float16* LOGF; bf16* RI; bf16* RG; const float* ssq; const float* lb_raw;
    __device__ __forceinline__ void operator()(EPI_ARGS) const {
        const int pn = u.col0 >> 8, part = pn >> 2; const unsigned rb = u.row0 + wr * 64 + fr, cb = (pn & 3) * 256 + wc * 32 + 8 * fq;
        LOAD_RSTD(rr, ssq, rb);
        if (part == 1) {
            f32x4 lbv[2][2];
            FOR_BN { const unsigned ch = cb + bj * 128 + n * 4; const f32x4 l0 = atc<f32x4>(lb_raw, ch * 4u), l1 = atc<f32x4>(lb_raw, (D + ch) * 4u);
#pragma unroll
                for (int e = 0; e < 4; ++e) lbv[bj][n][e] = __builtin_amdgcn_rcpf(1.f + __expf(l0[e] - l1[e])); }
            FOR_AM { const unsigned row = rb + ai * 128 + m * 16; const float r = rr[ai][m];
                FOR_BN { const f32x4 v = acc[ai][bj][m][n] * r; f32x4 o;
#pragma unroll
                    for (int e = 0; e < 4; ++e) { const float lb = lbv[bj][n][e]; const float sg = __builtin_amdgcn_rcpf(1.f + __expf(-v[e])); o[e] = lb + (1.f - lb) * sg; }
                    at<f16x4>(LOGF, (row * D + cb + bj * 128 + n * 4) * 2u) = __builtin_convertvector(o, f16x4); }
                EPI_FENCE(); }
        } else if (part == 2) {
            FOR_AM { const unsigned row = rb + ai * 128 + m * 16; const float r = rr[ai][m];
                FOR_BJ { at<u32x4>(RI, (row * D + cb + bj * 128) * 2u) = pk8(acc[ai][bj][m][0] * r, acc[ai][bj][m][1] * r); }
                EPI_FENCE(); }
        } else {
            bf16* dst = part == 0 ? RQ : RG;
            FOR_AM { const unsigned row = rb + ai * 128 + m * 16; const float r = rr[ai][m];
                FOR_BJ { f32x4 v0 = acc[ai][bj][m][0] * r, v1 = acc[ai][bj][m][1] * r;
#pragma unroll
                    for (int e = 0; e < 4; ++e) { v0[e] = silu_f(v0[e]); v1[e] = silu_f(v1[e]); }
                    at<u32x4>(dst, (row * D + cb + bj * 128) * 2u) = pk8(v0, v1); }
                EPI_FENCE(); }
        }
    }
};
struct EpiQ { bf16* Q; const float* ssq; float scale;
    __device__ __forceinline__ void operator()(EPI_ARGS) const {
        const unsigned rb = u.row0 + wr * 64 + fr, cb = u.col0 + wc * 32 + 8 * fq;
        FOR_AM { const unsigned row = rb + ai * 128 + m * 16; const float r = ssq_rstd(ssq, row) * scale;
            FOR_BN { at<u32x2>(Q, (row * D + cb + bj * 128 + n * 4) * 2u) = pk4(acc[ai][bj][m][n] * r); }
            EPI_FENCE(); }
    }
};
struct EpiKV { float* outK; float* outV; bf16* MK; bf16* VT; const float* mssq;
    __device__ __forceinline__ void operator()(EPI_ARGS) const {
        const unsigned rb = u.row0 + wr * 64 + fr, cb = (u.col0 & (D - 1)) + wc * 32 + 8 * fq; const bool isK = u.col0 < D;
        float rr[2][4]; FOR_AM rr[ai][m] = rsqrtf(atc<float>(mssq, (rb + ai * 128 + m * 16) * 4u) * (1.f / D) + EPS);
        FOR_AM { const unsigned row = rb + ai * 128 + m * 16; const float r = rr[ai][m];
            FOR_BJ { const unsigned col = cb + bj * 128; const f32x4 v0 = acc[ai][bj][m][0] * r, v1 = acc[ai][bj][m][1] * r;
                float* of = isK ? outK : outV; bf16* ob = isK ? MK : VT;
                at<f32x4>(of, (row * D + col) * 4u) = v0; at<f32x4>(of, (row * D + col) * 4u + 16u) = v1; at<u32x4>(ob, (row * D + col) * 2u) = pk8(v0, v1); }
            EPI_FENCE(); }
    }
};
struct EpiSoftmax { bf16* P; LAS float* scr; const float* ssq;
    __device__ __forceinline__ void operator()(EPI_ARGS) const {
        LAS float* mx = scr; LAS float* sm = scr + 1024;
        const unsigned rl0 = wr * 64 + fr, cb = u.col0 + wc * 32 + 8 * fq;
        { LOAD_RSTD(s1, ssq, u.row0 + rl0);
        FOR_AM { const unsigned rl = rl0 + ai * 128 + m * 16; const float sc = s1[ai][m] * QSCALE; float v = -3.0e38f;
            FOR_BN { const f32x4 a = acc[ai][bj][m][n]; v = fmaxf(v, fmaxf(fmaxf(a[0], a[1]), fmaxf(a[2], a[3]))); }
            v *= sc;
            v = fmaxf(v, __shfl_xor(v, 16)); v = fmaxf(v, __shfl_xor(v, 32));
            if (fq == 0) mx[rl * 4 + wc] = v; } }
        LDS_WAIT(); __builtin_amdgcn_s_barrier(); asm volatile("" ::: "memory");
        { LOAD_RSTD(s2, ssq, u.row0 + rl0);
        FOR_AM { const unsigned rl = rl0 + ai * 128 + m * 16; const float sc = s2[ai][m] * QSCALE;
            const f32x4 q = *(LAS f32x4*)(mx + rl * 4); const float M = fmaxf(fmaxf(q[0], q[1]), fmaxf(q[2], q[3]));
            float s = 0.f;
            FOR_BN { const f32x4 a = acc[ai][bj][m][n] * sc; s += (__builtin_amdgcn_exp2f(a[0] - M) + __builtin_amdgcn_exp2f(a[1] - M)) + (__builtin_amdgcn_exp2f(a[2] - M) + __builtin_amdgcn_exp2f(a[3] - M)); }
            s += __shfl_xor(s, 16); s += __shfl_xor(s, 32);
            if (fq == 0) sm[rl * 4 + wc] = s; EPI_FENCE(); } }
        LDS_WAIT(); __builtin_amdgcn_s_barrier(); asm volatile("" ::: "memory");
        { LOAD_RSTD(s3, ssq, u.row0 + rl0);
        FOR_AM { const unsigned rl = rl0 + ai * 128 + m * 16; const float sc = s3[ai][m] * QSCALE;
            const f32x4 q = *(LAS f32x4*)(sm + rl * 4); const float inv = __builtin_amdgcn_rcpf((q[0] + q[1]) + (q[2] + q[3]));
            const f32x4 qm = *(LAS f32x4*)(mx + rl * 4); const float M = fmaxf(fmaxf(qm[0], qm[1]), fmaxf(qm[2], qm[3]));
            FOR_BJ { f32x4 pv[2];
#pragma unroll
                for (int n = 0; n < 2; ++n) { const f32x4 a = acc[ai][bj][m][n] * sc; pv[n] = (f32x4){__builtin_amdgcn_exp2f(a[0] - M) * inv, __builtin_amdgcn_exp2f(a[1] - M) * inv, __builtin_amdgcn_exp2f(a[2] - M) * inv, __builtin_amdgcn_exp2f(a[3] - M) * inv}; }
                at<u32x4>(P, ((u.row0 + rl) * D + cb + bj * 128) * 2u) = pk8(pv[0], pv[1]); }
            EPI_FENCE(); } }
    }
};
struct EpiPlain { bf16* O; unsigned pitch;
    __device__ __forceinline__ void operator()(EPI_ARGS) const {
        const unsigned rb = u.row0 + wr * 64 + fr, cb = u.col0 + wc * 32 + 8 * fq;
        FOR_AM { const unsigned row = rb + ai * 128 + m * 16;
            FOR_BJ { at<u32x4>(O, (row * pitch + cb + bj * 128) * 2u) = pk8(acc[ai][bj][m][0], acc[ai][bj][m][1]); }
            EPI_FENCE(); }
    }
};

}

__device__ __forceinline__ void transpose_item(const float* W, int K, int N, const float* gain, bf16* WT, int k0, int n0, int orow0, LAS float* scr, int lane) {
    f32x4 v[16]; const int kr = lane >> 4, c4 = (lane & 15) * 4;
#pragma unroll
    for (int i = 0; i < 16; ++i) v[i] = __builtin_nontemporal_load((const f32x4*)(W + (size_t)(k0 + 4 * i + kr) * N + n0 + c4));
#pragma unroll
    for (int i = 0; i < 16; ++i) { const int kk = 4 * i + kr; const float g = gain ? gain[k0 + kk] : 1.f; LAS float* d = scr + kk * 65 + c4;
        d[0] = v[i][0] * g; d[1] = v[i][1] * g; d[2] = v[i][2] * g; d[3] = v[i][3] * g; }
    LDS_WAIT(); asm volatile("" ::: "memory");
    const int c = lane & 7;
#pragma unroll
    for (int j = 0; j < 8; ++j) { const int n = (lane >> 3) + 8 * j; const LAS float* s = scr + (8 * c) * 65 + n;
        u32x4 o; o.x = pk2(s[0 * 65], s[1 * 65]); o.y = pk2(s[2 * 65], s[3 * 65]); o.z = pk2(s[4 * 65], s[5 * 65]); o.w = pk2(s[6 * 65], s[7 * 65]);
        *(u32x4*)(WT + (size_t)(orow0 + n) * K + k0 + 8 * c) = o; }
    LDS_WAIT(); asm volatile("" ::: "memory");
}

struct Args { const float* in[29]; float* out; unsigned char* ws; int ph_lo, ph_hi; };

__device__ __forceinline__ int map_row(int map, int n0) {
    if (map == 1) return (n0 >> 7) * 256 + (n0 & 127);
    if (map == 2) return (n0 >> 7) * 256 + 128 + (n0 & 127);
    if (map == 3) { if (n0 < D) return n0; if (n0 < 2 * D) { const int j = n0 - D; return D + (j >> 7) * 256 + (j & 127); } const int j = n0 - 2 * D; return D + (j >> 7) * 256 + 128 + (j & 127); }
    return n0;
}

__device__ __forceinline__ void prologue(const Args& a, const int z, LAS unsigned char* lds, int vcu, int G) {
    const int tid = otid(), lane = tid & 63, wave = tid >> 6;
    const int gw = vcu * NWAVES + wave, NGW = G * NWAVES;
    unsigned char* ws = a.ws + z;
    LAS float* scr = (LAS float*)(lds + wave * 16640);
    int off = 0;
    for (int job = 0; job < 26; ++job) {
        const float* W; const float* gain = nullptr; bf16* dst; int K = D, N = D, map = 0;
        if (job < 18) { const int li = job / 9, j = job % 9;
            switch (j) {
                case 0: W = a.in[8 + z] + (size_t)li * D * FF; gain = a.in[7 + z] + li * D; dst = (bf16*)(ws + WS_WGU + (size_t)(li * 2 + 0) * SZ_WGU); N = FF; map = 1; break;
                case 1: W = a.in[9 + z] + (size_t)li * D * FF; gain = a.in[7 + z] + li * D; dst = (bf16*)(ws + WS_WGU + (size_t)(li * 2 + 0) * SZ_WGU); N = FF; map = 2; break;
                case 2: W = a.in[10 + z] + (size_t)li * D * FF; dst = (bf16*)(ws + WS_WD + (size_t)(li * 2 + 0) * SZ_WD); K = FF; break;
                case 3: W = a.in[25 + z] + (size_t)li * D * FF; gain = a.in[24 + z] + li * D; dst = (bf16*)(ws + WS_WGU + (size_t)(li * 2 + 1) * SZ_WGU); N = FF; map = 1; break;
                case 4: W = a.in[26 + z] + (size_t)li * D * FF; gain = a.in[24 + z] + li * D; dst = (bf16*)(ws + WS_WGU + (size_t)(li * 2 + 1) * SZ_WGU); N = FF; map = 2; break;
                case 5: W = a.in[27 + z] + (size_t)li * D * FF; dst = (bf16*)(ws + WS_WD + (size_t)(li * 2 + 1) * SZ_WD); K = FF; break;
                case 6: W = a.in[21 + z] + (size_t)li * D * D; gain = a.in[19 + z] + li * D; dst = (bf16*)(ws + WS_WQ + (size_t)li * SZ_DD); break;
                case 7: W = a.in[22 + z] + (size_t)li * D * 2 * D; gain = a.in[20 + z] + li * D; dst = (bf16*)(ws + WS_WKV + (size_t)li * 2 * SZ_DD); N = 2 * D; break;
                default: W = a.in[23 + z] + (size_t)li * D * D; dst = (bf16*)(ws + WS_WO + (size_t)li * SZ_DD); break;
            }
        } else {
            switch (job) {
                case 18: W = a.in[12 + z]; gain = a.in[11 + z]; dst = (bf16*)(ws + WS_WCI); N = 3 * D; map = 3; break;
                case 19: W = a.in[14 + z]; dst = (bf16*)(ws + WS_WMO); break;
                case 20: W = a.in[16 + z]; gain = a.in[11 + z] + D; dst = (bf16*)(ws + WS_WRI); N = 4 * D; break;
                case 21: W = a.in[18 + z]; dst = (bf16*)(ws + WS_WMO + SZ_DD); break;
                default: W = nullptr; dst = nullptr; break;
            }
        }
        if (!W) continue;
        const int nblk = N / 64, nit = (K / 64) * nblk;
#pragma unroll 1
        for (int it = (gw - off + NGW) % NGW; it < nit; it += NGW) { const int kb = it / nblk, nb = it % nblk;
            transpose_item(W, K, N, gain, dst, kb * 64, nb * 64, map_row(map, nb * 64), scr, lane); }
        off = (off + nit) % NGW;
    }
    bf16* XB = (bf16*)(ws + WS_XB); float* SSQ = (float*)(ws + WS_SSQ);
#pragma unroll 1
    for (int m0 = gw; m0 < MT; m0 += 4 * NGW) {
        f32x4 v[4][4]; int mm[4];
#pragma unroll
        for (int q = 0; q < 4; ++q) { const int m = m0 + q * NGW; mm[q] = m < MT ? m : m0;
            const f32x4* xr = (const f32x4*)(mm[q] < MP ? a.in[0 + z] + (size_t)mm[q] * D : a.in[1 + z] + (size_t)(mm[q] - MP) * D) + lane;
#pragma unroll
            for (int j = 0; j < 4; ++j) v[q][j] = __builtin_nontemporal_load(xr + 64 * j); }
#pragma unroll
        for (int q = 0; q < 4; ++q) { const int m = m0 + q * NGW; if (m < MT) { float s = 0.f;
#pragma unroll
            for (int j = 0; j < 4; ++j) { s += (v[q][j][0] * v[q][j][0] + v[q][j][1] * v[q][j][1]) + (v[q][j][2] * v[q][j][2] + v[q][j][3] * v[q][j][3]); ((u32x2*)(XB + (size_t)m * D))[lane + 64 * j] = pg8::pk4(v[q][j]); }
            s = wave_sum(s); if (lane == 0) ((unsigned*)SSQ)[m] = (unsigned)(s * pg8::SSQ_FX + 0.5f); } }
    }
    for (int i = gw * 64 + lane; i < 2 * D * D / 8; i += NGW * 64) { const int l = i >> 17, e0 = (i & 131071) * 8, kk = e0 >> 10;
        const float g = a.in[19 + z][l * D + kk]; const f32x4* p = (const f32x4*)(a.in[21 + z] + (size_t)l * D * D + e0); const f32x4 v0 = p[0] * g, v1 = p[1] * g;
        u32x4 o; o.x = pk2(v0[0], v0[1]); o.y = pk2(v0[2], v0[3]); o.z = pk2(v1[0], v1[1]); o.w = pk2(v1[2], v1[3]);
        *(u32x4*)((bf16*)(ws + WS_WQN) + (size_t)l * D * D + e0) = o; }
    bf16* MEMB = (bf16*)(ws + WS_MEMB); float* MSSQ = (float*)(ws + WS_MSSQ);
    for (int m = gw; m < MEMR; m += NGW) { const f32x4* xr = (const f32x4*)(a.in[2 + z] + (size_t)m * D) + lane; float s = 0.f;
#pragma unroll
        for (int j = 0; j < 4; ++j) { const f32x4 v = xr[64 * j]; s += (v[0] * v[0] + v[1] * v[1]) + (v[2] * v[2] + v[3] * v[3]); u32x2 w; w.x = pk2(v[0], v[1]); w.y = pk2(v[2], v[3]); ((u32x2*)(MEMB + (size_t)m * D))[lane + 64 * j] = w; }
        s = wave_sum(s); if (lane == 0) MSSQ[m] = s; }
    for (int i = vcu * NTHR + tid; i < 8 * MPAD; i += G * NTHR) SSQ[MPAD + i] = 0.f;
}

__device__ __forceinline__ void ld8(const bf16* p, float (&f)[8]) { const u32x4 w = *(const u32x4*)p; f[0] = bflo(w.x); f[1] = bfhi(w.x); f[2] = bflo(w.y); f[3] = bfhi(w.y); f[4] = bflo(w.z); f[5] = bfhi(w.z); f[6] = bflo(w.w); f[7] = bfhi(w.w); }
__device__ __forceinline__ void up8(const u32x4 w, float (&f)[8]) { f[0] = bflo(w.x); f[1] = bfhi(w.x); f[2] = bflo(w.y); f[3] = bfhi(w.y); f[4] = bflo(w.z); f[5] = bfhi(w.z); f[6] = bflo(w.w); f[7] = bfhi(w.w); }
__device__ __forceinline__ void conv_phase(const Args& a, const int z, int vcu, int G) {
    unsigned char* ws = a.ws + z; const bf16* CB = (const bf16*)(ws + WS_M1); const bf16* CV = (const bf16*)(ws + WS_M2); bf16* Gb = (bf16*)(ws + WS_G);
    const float* wc = a.in[13 + z]; const float* st = a.in[3 + z]; float* out_cs = a.out + OUT_CS;
    const int nth = G * NTHR, gt = vcu * NTHR + otid(), ch = (gt & 127) * 8;
    float w0[8], w1[8], w2[8];
#pragma unroll
    for (int e = 0; e < 8; ++e) { w0[e] = wc[ch + e]; w1[e] = wc[D + ch + e]; w2[e] = wc[2 * D + ch + e]; }
    if ((nth & 127) == 0) {
#pragma unroll 1
        for (int it0 = gt; it0 < MP * 128; it0 += 4 * nth) {
            u32x4 B[4], V2[4], V1[4], V0[4];
#pragma unroll
            for (int j = 0; j < 4; ++j) { const int it = it0 + j * nth; const int row = it < MP * 128 ? (it >> 7) : 0; const int t = row & (T - 1);
                B[j] = *(const u32x4*)(CB + (size_t)row * D + ch); V2[j] = *(const u32x4*)(CV + (size_t)row * D + ch);
                V1[j] = *(const u32x4*)(CV + (size_t)(row - (t >= 1 ? 1 : 0)) * D + ch); V0[j] = *(const u32x4*)(CV + (size_t)(row - (t >= 2 ? 2 : 0)) * D + ch); }
#pragma unroll
            for (int j = 0; j < 4; ++j) { const int it = it0 + j * nth; if (it < MP * 128) { const int row = it >> 7, t = row & (T - 1);
                float b[8], v2[8], v1[8], v0[8], g[8]; up8(B[j], b); up8(V2[j], v2); up8(V1[j], v1); up8(V0[j], v0);
                const float m1 = t >= 1 ? 1.f : 0.f, m0 = t >= 2 ? 1.f : 0.f;
#pragma unroll
                for (int e = 0; e < 8; ++e) g[e] = b[e] * (w0[e] * (v0[e] * m0) + w1[e] * (v1[e] * m1) + w2[e] * v2[e]);
                u32x4 w; w.x = pk2(g[0], g[1]); w.y = pk2(g[2], g[3]); w.z = pk2(g[4], g[5]); w.w = pk2(g[6], g[7]);
                *(u32x4*)(Gb + (size_t)row * D + ch) = w; } }
        }
        if (gt < NS * 128) { const int s = gt >> 7, row = MP + s; float b[8], v2[8], g[8];
            ld8(CB + (size_t)row * D + ch, b); ld8(CV + (size_t)row * D + ch, v2);
            const f32x4* p0 = (const f32x4*)(st + ((size_t)s * 2 + 0) * D + ch); const f32x4* p1 = (const f32x4*)(st + ((size_t)s * 2 + 1) * D + ch);
            const f32x4 a0 = p0[0], a1 = p0[1], b0 = p1[0], b1 = p1[1];
            f32x4* o = (f32x4*)(out_cs + ((size_t)s * 2 + 0) * D + ch); o[0] = b0; o[1] = b1;
#pragma unroll
            for (int e = 0; e < 8; ++e) { const float x0 = e < 4 ? a0[e & 3] : a1[e & 3], x1 = e < 4 ? b0[e & 3] : b1[e & 3]; g[e] = b[e] * (w0[e] * x0 + w1[e] * x1 + w2[e] * v2[e]); }
            u32x4 w; w.x = pk2(g[0], g[1]); w.y = pk2(g[2], g[3]); w.z = pk2(g[4], g[5]); w.w = pk2(g[6], g[7]);
            *(u32x4*)(Gb + (size_t)row * D + ch) = w; }
        return;
    }
    for (int it = gt; it < MT * 128; it += nth) {
        const int row = it >> 7, chx = (it & 127) * 8; float b[8], v2[8], v1[8], v0[8];
        ld8(CB + (size_t)row * D + chx, b); ld8(CV + (size_t)row * D + chx, v2);
        if (row < MP) { const int t = row & (T - 1);
            if (t >= 1) ld8(CV + (size_t)(row - 1) * D + chx, v1); else { for (int e = 0; e < 8; ++e) v1[e] = 0.f; }
            if (t >= 2) ld8(CV + (size_t)(row - 2) * D + chx, v0); else { for (int e = 0; e < 8; ++e) v0[e] = 0.f; }
        } else { const int s = row - MP; const f32x4* p0 = (const f32x4*)(st + ((size_t)s * 2 + 0) * D + chx); const f32x4* p1 = (const f32x4*)(st + ((size_t)s * 2 + 1) * D + chx);
            const f32x4 a0 = p0[0], a1 = p0[1], b0 = p1[0], b1 = p1[1];
            for (int e = 0; e < 4; ++e) { v0[e] = a0[e]; v0[4 + e] = a1[e]; v1[e] = b0[e]; v1[4 + e] = b1[e]; }
            f32x4* o = (f32x4*)(out_cs + ((size_t)s * 2 + 0) * D + chx); o[0] = b0; o[1] = b1; }
        float g[8];
#pragma unroll
        for (int e = 0; e < 8; ++e) g[e] = b[e] * (wc[chx + e] * v0[e] + wc[D + chx + e] * v1[e] + wc[2 * D + chx + e] * v2[e]);
        u32x4 w; w.x = pk2(g[0], g[1]); w.y = pk2(g[2], g[3]); w.z = pk2(g[4], g[5]); w.w = pk2(g[6], g[7]);
        *(u32x4*)(Gb + (size_t)row * D + chx) = w;
    }
}

__device__ __forceinline__ void sample_attn_unit(LAS unsigned char* lds, const float* Kc, const float* Vc, const bf16* Q, bf16* O, int s, int hp) {
    const int tid = otid(), lane = tid & 63, w = tid >> 6;
    LAS float* qs = (LAS float*)lds; LAS float* sc = qs + 512; LAS float* red = sc + 512;
    qs[tid] = bf2f(Q[(size_t)(MP + s) * D + hp * 512 + tid]);
    __syncthreads();
    const f32x4 qa = *(LAS f32x4*)(qs + 4 * lane), qb = *(LAS f32x4*)(qs + 256 + 4 * lane);
    const float* Kb = Kc + ((size_t)s * NMEM * 4 + hp * 2) * 256 + 4 * lane;
    for (int j = 0; j < 32; j += 8) {
        f32x4 ka[8], kb[8];
#pragma unroll
        for (int jj = 0; jj < 8; ++jj) { const int n = w + 8 * (j + jj); ka[jj] = __builtin_nontemporal_load((const f32x4*)(Kb + (size_t)n * 1024)); kb[jj] = __builtin_nontemporal_load((const f32x4*)(Kb + (size_t)n * 1024 + 256)); }
#pragma unroll
        for (int jj = 0; jj < 8; ++jj) { const int n = w + 8 * (j + jj);
            float pa = (qa[0] * ka[jj][0] + qa[1] * ka[jj][1]) + (qa[2] * ka[jj][2] + qa[3] * ka[jj][3]);
            float pb = (qb[0] * kb[jj][0] + qb[1] * kb[jj][1]) + (qb[2] * kb[jj][2] + qb[3] * kb[jj][3]);
            pa = wave_sum(pa); pb = wave_sum(pb);
            if (lane == 0) { sc[n] = pa; sc[256 + n] = pb; } }
    }
    __syncthreads();
    if (w < 2) { LAS float* p = sc + 256 * w; float v[4]; float m = -3.0e38f;
#pragma unroll
        for (int i = 0; i < 4; ++i) { v[i] = p[lane + 64 * i]; m = fmaxf(m, v[i]); }
        m = wave_max(m); float sum = 0.f;
#pragma unroll
        for (int i = 0; i < 4; ++i) { v[i] = __builtin_amdgcn_exp2f(v[i] - m); sum += v[i]; }
        sum = wave_sum(sum); const float inv = 1.f / sum;
#pragma unroll
        for (int i = 0; i < 4; ++i) p[lane + 64 * i] = v[i] * inv; }
    __syncthreads();
    const int dq = tid & 127, ng = tid >> 7, hsel = dq >> 6;
    const float* Vb = Vc + ((size_t)s * NMEM * 4 + hp * 2) * 256 + 4 * dq;
    f32x4 acc = (f32x4){0.f, 0.f, 0.f, 0.f};
#pragma unroll 16
    for (int j = 0; j < 64; ++j) { const int n = ng + 4 * j; const float p = sc[hsel * 256 + n]; const f32x4 v = __builtin_nontemporal_load((const f32x4*)(Vb + (size_t)n * 1024)); acc += v * p; }
    *(LAS f32x4*)(red + ng * 512 + 4 * dq) = acc;
    __syncthreads();
    if (tid < 128) { f32x4 o = *(LAS f32x4*)(red + 4 * tid) + *(LAS f32x4*)(red + 512 + 4 * tid) + *(LAS f32x4*)(red + 1024 + 4 * tid) + *(LAS f32x4*)(red + 1536 + 4 * tid);
        u32x2 wv; wv.x = pk2(o[0], o[1]); wv.y = pk2(o[2], o[3]); *(u32x2*)(O + (size_t)(MP + s) * D + hp * 512 + 4 * tid) = wv; }
    __syncthreads();
}

__device__ __forceinline__ void sample_rec_unit(LAS unsigned char* lds, const Args& a, const int z, int s, int h) {
    const int tid = otid(), lane = tid & 63, w = tid >> 6;
    unsigned char* ws = a.ws + z; const bf16* RQ = (const bf16*)(ws + WS_M1); const bf16* RI = (const bf16*)(ws + WS_M2); const bf16* RG = (const bf16*)(ws + WS_RG); const _Float16* LOGF = (const _Float16*)(ws + WS_LOGF);
    bf16* GO = (bf16*)(ws + WS_G);
    LAS float* fL = (LAS float*)lds; LAS float* kL = fL + 128; LAS float* qL = kL + 128; LAS float* iL = qL + 128; LAS float* red = iL + 128; LAS float* tmp = red + 16 * 128;
    const size_t rbase = (size_t)(MP + s) * D + h * 128;
    if (tid < 128) { const float f = (float)LOGF[rbase + tid]; fL[tid] = f; kL[tid] = 1.f - f; qL[tid] = bf2f(RQ[rbase + tid]); iL[tid] = bf2f(RI[rbase + tid]); }
    __syncthreads();
    const int vq = tid & 31, kq = tid >> 5;
    const f32x4 iv = *(LAS f32x4*)(iL + 4 * vq); f32x4 o = (f32x4){0.f, 0.f, 0.f, 0.f};
    const size_t sb = ((size_t)(s * 8 + h) * 128) * 128;
    const float* S0 = a.in[4 + z] + sb; float* So = a.out + OUT_RS + sb;
    f32x4 s0v[8];
#pragma unroll
    for (int j = 0; j < 8; ++j) s0v[j] = __builtin_nontemporal_load((const f32x4*)(S0 + (kq + 16 * j) * 128 + 4 * vq));
#pragma unroll
    for (int j = 0; j < 8; ++j) { const int k = kq + 16 * j; const f32x4 sn = s0v[j] * fL[k] + iv * kL[k];
        *(f32x4*)(So + k * 128 + 4 * vq) = sn; o += sn * qL[k]; }
    *(LAS f32x4*)(red + kq * 128 + 4 * vq) = o;
    __syncthreads();
    float ov = 0.f;
    if (tid < 128) {
#pragma unroll
        for (int j = 0; j < 16; ++j) ov += red[j * 128 + tid];
        const float ss = wave_sum(ov * ov); if (lane == 0) tmp[w] = ss; }
    __syncthreads();
    if (tid < 128) { const float rstd = rsqrtf((tmp[0] + tmp[1]) * (1.f / 128.f) + EPS);
        GO[rbase + tid] = (bf16)f2bf(ov * rstd * a.in[17 + z][tid] * bf2f(RG[rbase + tid])); }
    __syncthreads();
}

__device__ __forceinline__ f32x4 mfma16(bf16x8 a, bf16x8 b, f32x4 c) { return __builtin_amdgcn_mfma_f32_16x16x32_bf16(a, b, c, 0, 0, 0); }
constexpr int G1_QB = 0, G1_KI = 17408, G1_KL = 34816, G1_VT = 53248, G1_AT = 71680, G1_TOT = 80896;
struct G1In { float f[16]; unsigned q[16]; unsigned v[16]; };
__device__ __forceinline__ void gla_g1_load(unsigned char* ws, int unit, int tid, G1In& in) {
    const _Float16* FG = (const _Float16*)(ws + WS_LOGF); const bf16* RQ = (const bf16*)(ws + WS_M1); const bf16* RI = (const bf16*)(ws + WS_M2);
    const int bh = unit >> 5, c = unit & 31, b = bh >> 3, h = bh & 7, row0 = b * T + c * 64;
    const size_t gb = (size_t)(row0 + 16 * (tid >> 7)) * D + h * 128 + (tid & 127);
#pragma unroll
    for (int j = 0; j < 16; ++j) { in.f[j] = (float)FG[gb + (size_t)j * D]; in.q[j] = RQ[gb + (size_t)j * D]; in.v[j] = RI[gb + (size_t)j * D]; }
}
#define G1_BAR() do { LDS_WAIT(); __builtin_amdgcn_s_barrier(); asm volatile("" ::: "memory"); } while (0)
__device__ __forceinline__ void gla_g1_compute(LAS unsigned char* lds, unsigned char* ws, int unit, int tid, const G1In& in) {
    const int lane = tid & 63, w = tid >> 6, r = lane & 15, q = lane >> 4;
    bf16* QBG = (bf16*)(ws + WS_QBG); bf16* OINTRA = (bf16*)(ws + WS_OINTRA); bf16* UT = (bf16*)(ws + WS_UT); float* DEC = (float*)(ws + WS_DEC);
    const int bh = unit >> 5, c = unit & 31, b = bh >> 3, h = bh & 7, row0 = b * T + c * 64, colh = h * 128;
    LAS bf16* QbL = (LAS bf16*)(lds + G1_QB); LAS bf16* KiL = (LAS bf16*)(lds + G1_KI); LAS bf16* KlT = (LAS bf16*)(lds + G1_KL); LAS bf16* vT = (LAS bf16*)(lds + G1_VT); LAS bf16* atL = (LAS bf16*)(lds + G1_AT);
    LAS float* tot = (LAS float*)(lds + G1_TOT);
    const int k = tid & 127, part = tid >> 7, t0 = 16 * part;
    float pc[16]; float run = 1.f;
#pragma unroll
    for (int j = 0; j < 16; ++j) { run *= in.f[j]; pc[j] = run; }
    tot[part * 128 + k] = run;
    G1_BAR();
    float offp = 1.f, eL = 1.f;
#pragma unroll
    for (int p = 0; p < 4; ++p) { const float tv = tot[p * 128 + k]; eL *= tv; if (p < part) offp *= tv; }
    unsigned kl[8];
#pragma unroll
    for (int j = 0; j < 16; j += 2) {
        const float e0 = pc[j] * offp, e1 = pc[j + 1] * offp, i0 = __builtin_amdgcn_rcpf(e0), i1 = __builtin_amdgcn_rcpf(e1);
        const float ki0 = (1.f - in.f[j]) * i0, ki1 = (1.f - in.f[j + 1]) * i1;
        const unsigned qb = pk2(bf2f(in.q[j]) * e0, bf2f(in.q[j + 1]) * e1), ki = pk2(ki0, ki1);
        QbL[(t0 + j) * 136 + k] = (bf16)(qb & 0xffffu); QbL[(t0 + j + 1) * 136 + k] = (bf16)(qb >> 16);
        KiL[(t0 + j) * 136 + k] = (bf16)(ki & 0xffffu); KiL[(t0 + j + 1) * 136 + k] = (bf16)(ki >> 16);
        kl[j >> 1] = pk2(ki0 * eL, ki1 * eL); }
    { u32x4 w0, w1; w0.x = kl[0]; w0.y = kl[1]; w0.z = kl[2]; w0.w = kl[3]; w1.x = kl[4]; w1.y = kl[5]; w1.z = kl[6]; w1.w = kl[7];
      *(LAS u32x4*)(KlT + k * 72 + t0) = w0; *(LAS u32x4*)(KlT + k * 72 + t0 + 8) = w1;
      w0.x = in.v[0] | (in.v[1] << 16); w0.y = in.v[2] | (in.v[3] << 16); w0.z = in.v[4] | (in.v[5] << 16); w0.w = in.v[6] | (in.v[7] << 16);
      w1.x = in.v[8] | (in.v[9] << 16); w1.y = in.v[10] | (in.v[11] << 16); w1.z = in.v[12] | (in.v[13] << 16); w1.w = in.v[14] | (in.v[15] << 16);
      *(LAS u32x4*)(vT + k * 72 + t0) = w0; *(LAS u32x4*)(vT + k * 72 + t0 + 8) = w1; }
    if (part == 0) DEC[(size_t)unit * 128 + k] = eL;
    G1_BAR();
#pragma unroll
    for (int i = 0; i < 2; ++i) { const int idx = tid + 512 * i, t = idx >> 4, c16 = idx & 15; *(u32x4*)(QBG + (size_t)(row0 + t) * D + colh + 8 * c16) = *(const LAS u32x4*)(QbL + t * 136 + 8 * c16); }
    { const int ti = w >> 1;
#pragma unroll
      for (int sx = 0; sx < 2; ++sx) { const int sj = 2 * (w & 1) + sx; f32x4 acc = (f32x4){0.f, 0.f, 0.f, 0.f};
        if (sj <= ti) {
#pragma unroll
        for (int ks = 0; ks < 4; ++ks) { const bf16x8 av = *(const LAS bf16x8*)(QbL + (16 * ti + r) * 136 + 32 * ks + 8 * q); const bf16x8 bv = *(const LAS bf16x8*)(KiL + (16 * sj + r) * 136 + 32 * ks + 8 * q); acc = mfma16(av, bv, acc); } }
#pragma unroll
        for (int e = 0; e < 4; ++e) { const int t = 16 * ti + 4 * q + e, s = 16 * sj + r; atL[t * 72 + s] = (bf16)f2bf(s <= t ? acc[e] : 0.f); } } }
    G1_BAR();
    { const int tj = w & 3;
#pragma unroll
      for (int vx = 0; vx < 4; ++vx) { const int vi = 4 * (w >> 2) + vx; f32x4 acc = (f32x4){0.f, 0.f, 0.f, 0.f};
#pragma unroll
        for (int ks = 0; ks < 2; ++ks) { const bf16x8 av = *(const LAS bf16x8*)(vT + (16 * vi + r) * 72 + 32 * ks + 8 * q); const bf16x8 bv = *(const LAS bf16x8*)(atL + (16 * tj + r) * 72 + 32 * ks + 8 * q); acc = mfma16(av, bv, acc); }
        *(u32x2*)(OINTRA + (size_t)(row0 + 16 * tj + r) * D + colh + 16 * vi + 4 * q) = pg8::pk4(acc); } }
    { const int vj = w;
#pragma unroll
      for (int ki = 0; ki < 8; ++ki) { f32x4 acc = (f32x4){0.f, 0.f, 0.f, 0.f};
#pragma unroll
        for (int ks = 0; ks < 2; ++ks) { const bf16x8 av = *(const LAS bf16x8*)(KlT + (16 * ki + r) * 72 + 32 * ks + 8 * q); const bf16x8 bv = *(const LAS bf16x8*)(vT + (16 * vj + r) * 72 + 32 * ks + 8 * q); acc = mfma16(av, bv, acc); }
        *(u32x2*)(UT + (size_t)unit * 16384 + (size_t)(16 * vj + r) * 128 + 16 * ki + 4 * q) = pg8::pk4(acc); } }
    G1_BAR();
}
__device__ __forceinline__ void gla_g1_phase(LAS unsigned char* lds, unsigned char* ws, int bx, int G) {
    const int tid = otid(); G1In cur, nxt;
    if (bx < 2048) gla_g1_load(ws, bx, tid, cur);
#pragma unroll 1
    for (int u = bx; u < 2048; u += G) { const int un = u + G;
        if (un < 2048) gla_g1_load(ws, un, tid, nxt);
        gla_g1_compute(lds, ws, u, tid, cur);
        cur = nxt; }
    asm volatile("s_waitcnt vmcnt(0)" ::: "memory"); __syncthreads();
}
__device__ __forceinline__ void gla_g2(const Args& a, const int z, int vcu, int G) {
    unsigned char* ws = a.ws + z; const bf16* UT = (const bf16*)(ws + WS_UT); const float* DEC = (const float*)(ws + WS_DEC); bf16* SPT = (bf16*)(ws + WS_SPT); float* outp = a.out + OUT_RP;
    for (int it = vcu * NTHR + otid(); it < 64 * 128 * 32; it += G * NTHR) {
        const int k4 = it & 31, v = (it >> 5) & 127, bh = it >> 12; f32x4 S = (f32x4){0.f, 0.f, 0.f, 0.f};
        const size_t eo = (size_t)v * 128 + 4 * k4;
#pragma unroll 1
        for (int c0 = 0; c0 < 32; c0 += 8) { u32x2 uw[8]; f32x4 dd[8];
#pragma unroll
            for (int j = 0; j < 8; ++j) { const size_t unit = (size_t)bh * 32 + c0 + j; uw[j] = *(const u32x2*)(UT + unit * 16384 + eo); dd[j] = *(const f32x4*)(DEC + unit * 128 + 4 * k4); }
#pragma unroll
            for (int j = 0; j < 8; ++j) { const size_t unit = (size_t)bh * 32 + c0 + j; const f32x4 uu = (f32x4){bflo(uw[j].x), bfhi(uw[j].x), bflo(uw[j].y), bfhi(uw[j].y)};
                u32x2 wv; wv.x = pk2(S[0], S[1]); wv.y = pk2(S[2], S[3]); *(u32x2*)(SPT + unit * 16384 + eo) = wv;
                S = S * dd[j] + uu; } }
#pragma unroll
        for (int e = 0; e < 4; ++e) outp[((size_t)bh * 128 + 4 * k4 + e) * 128 + v] = S[e];
    }
}
__device__ __forceinline__ void gla_g3_phase(LAS unsigned char* lds, const Args& a, const int z, int bx, int G) {
    const int tid = otid(), lane = tid & 63, w = tid >> 6, r = lane & 15, q = lane >> 4;
    unsigned char* ws = a.ws + z; const bf16* QBG = (const bf16*)(ws + WS_QBG); const bf16* SPT = (const bf16*)(ws + WS_SPT); const bf16* OINTRA = (const bf16*)(ws + WS_OINTRA);
    const bf16* RG = (const bf16*)(ws + WS_RG); bf16* GO = (bf16*)(ws + WS_G); const float* gon = a.in[17 + z];
    constexpr int BUFB = 17408 + 34816 + 512;
    u32x4 pq[2], ps[4];
    { const int u = bx, bh = u >> 5, c = u & 31, row0 = (bh >> 3) * T + c * 64, colh = (bh & 7) * 128;
#pragma unroll
      for (int i = 0; i < 2; ++i) { const int idx = tid + 512 * i; pq[i] = *(const u32x4*)(QBG + (size_t)(row0 + (idx >> 4)) * D + colh + 8 * (idx & 15)); }
#pragma unroll
      for (int i = 0; i < 4; ++i) { const int idx = tid + 512 * i; ps[i] = *(const u32x4*)(SPT + (size_t)u * 16384 + (idx >> 4) * 128 + 8 * (idx & 15)); } }
    int par = 0;
#pragma unroll 1
    for (int u = bx; u < 2048; u += G, par ^= 1) {
        LAS bf16* QbL = (LAS bf16*)(lds + par * BUFB); LAS bf16* SL = (LAS bf16*)(lds + par * BUFB + 17408); LAS float* ssL = (LAS float*)(lds + par * BUFB + 17408 + 34816);
        const int bh = u >> 5, c = u & 31, row0 = (bh >> 3) * T + c * 64, colh = (bh & 7) * 128;
#pragma unroll
        for (int i = 0; i < 2; ++i) { const int idx = tid + 512 * i; *(LAS u32x4*)(QbL + (idx >> 4) * 136 + 8 * (idx & 15)) = pq[i]; }
#pragma unroll
        for (int i = 0; i < 4; ++i) { const int idx = tid + 512 * i; *(LAS u32x4*)(SL + (idx >> 4) * 136 + 8 * (idx & 15)) = ps[i]; }
        G1_BAR();
        const int un = u + G;
        if (un < 2048) { const int bh2 = un >> 5, c2 = un & 31, row2 = (bh2 >> 3) * T + c2 * 64, colh2 = (bh2 & 7) * 128;
#pragma unroll
            for (int i = 0; i < 2; ++i) { const int idx = tid + 512 * i; pq[i] = *(const u32x4*)(QBG + (size_t)(row2 + (idx >> 4)) * D + colh2 + 8 * (idx & 15)); }
#pragma unroll
            for (int i = 0; i < 4; ++i) { const int idx = tid + 512 * i; ps[i] = *(const u32x4*)(SPT + (size_t)un * 16384 + (idx >> 4) * 128 + 8 * (idx & 15)); } }
        const int tj = w & 3, vh = w >> 2, t = 16 * tj + r; f32x4 o[4]; float ss = 0.f;
        u32x2 ow[4], rg[4];
#pragma unroll
        for (int vx = 0; vx < 4; ++vx) { const size_t off = (size_t)(row0 + t) * D + colh + 16 * (4 * vh + vx) + 4 * q; ow[vx] = *(const u32x2*)(OINTRA + off); rg[vx] = *(const u32x2*)(RG + off); }
#pragma unroll
        for (int vx = 0; vx < 4; ++vx) { const int vi = 4 * vh + vx; f32x4 acc = (f32x4){bflo(ow[vx].x), bfhi(ow[vx].x), bflo(ow[vx].y), bfhi(ow[vx].y)};
#pragma unroll
            for (int ks = 0; ks < 4; ++ks) { const bf16x8 av = *(const LAS bf16x8*)(SL + (16 * vi + r) * 136 + 32 * ks + 8 * q); const bf16x8 bv = *(const LAS bf16x8*)(QbL + (16 * tj + r) * 136 + 32 * ks + 8 * q); acc = mfma16(av, bv, acc); }
            o[vx] = acc; ss += (acc[0] * acc[0] + acc[1] * acc[1]) + (acc[2] * acc[2] + acc[3] * acc[3]); }
        ss += __shfl_xor(ss, 16); ss += __shfl_xor(ss, 32);
        if (q == 0) ssL[vh * 64 + t] = ss;
        G1_BAR();
        const float rstd = rsqrtf((ssL[t] + ssL[64 + t]) * (1.f / 128.f) + EPS);
#pragma unroll
        for (int vx = 0; vx < 4; ++vx) { const int v0 = 16 * (4 * vh + vx) + 4 * q; const f32x4 gn = *(const f32x4*)(gon + v0); const size_t off = (size_t)(row0 + t) * D + colh + v0;
            u32x2 wv; wv.x = pk2(o[vx][0] * rstd * gn[0] * bflo(rg[vx].x), o[vx][1] * rstd * gn[1] * bfhi(rg[vx].x)); wv.y = pk2(o[vx][2] * rstd * gn[2] * bflo(rg[vx].y), o[vx][3] * rstd * gn[3] * bfhi(rg[vx].y));
            *(u32x2*)(GO + off) = wv; }
    }
    asm volatile("s_waitcnt vmcnt(0)" ::: "memory"); __syncthreads();
}

__device__ __forceinline__ int opaque_v0() { int z; asm volatile("v_mov_b32 %0, 0" : "=v"(z)); return z; }
__device__ __forceinline__ int opaque0() { int z; asm volatile("s_mov_b32 %0, 0" : "=s"(z)); return z; }
#define INP(i) (a.in[(i) + z])
constexpr int NSTEPS = 29;
struct GemmDesc { const char* A; const char* B; int lda, ldb, K, M, N; size_t bstride; };
__device__ __forceinline__ void gemm_desc(const Args& a, int gs, bool smp, GemmDesc& d) {
    unsigned char* ws = a.ws; const int li = gs >= 15 ? 1 : 0, st = gs - 2 - 13 * li;
    d.lda = D; d.ldb = D; d.K = D; d.M = MP; d.N = D; d.bstride = 0; d.A = (const char*)(ws + WS_XB);
    if (st == 0 || st == 11) { d.B = (const char*)(ws + WS_WGU + (size_t)(li * 2 + (st == 11)) * SZ_WGU); d.N = 2 * FF; d.M = MPAD; }
    else if (st == 1 || st == 12) { d.A = (const char*)(ws + WS_H); d.B = (const char*)(ws + WS_WD + (size_t)(li * 2 + (st == 12)) * SZ_WD); d.K = FF; d.lda = FF; d.ldb = FF; }
    else if (st == 2) { d.B = li == 0 ? (const char*)(ws + WS_WCI) : (const char*)(ws + WS_WRI); d.N = li == 0 ? 3 * D : 4 * D; }
    else if (st == 6) { d.A = (const char*)(ws + WS_G); d.B = (const char*)(ws + WS_WMO + (size_t)li * SZ_DD); }
    else if (st == 7) { if (smp) d.B = (const char*)(ws + WS_WQ + (size_t)li * SZ_DD); else { d.B = (const char*)(ws + WS_WQK + (size_t)li * 8 * SZ_DD); d.bstride = SZ_DD; } }
    else if (st == 8) { d.A = (const char*)(ws + WS_P); d.B = (const char*)(ws + WS_VWT + (size_t)li * 8 * SZ_DD); d.ldb = 8 * D; d.bstride = (size_t)D * 2; }
    else { d.A = (const char*)(ws + WS_O); d.B = (const char*)(ws + WS_WO + (size_t)li * SZ_DD); }
}
namespace pg8 {
struct SchedAny { const Args& a; int gs, G, c;
    __device__ __forceinline__ bool next(int i, Unit& u) const {
        const int g2 = gs + opaque0(); GemmDesc d; gemm_desc(a, g2, false, d);
        Sched2D s; s.A = d.A; s.B = d.B; s.bstride = d.bstride; s.lda = d.lda; s.ldb = d.ldb; s.nM = d.M / BM; s.nN = d.N / BM; s.nwg = s.nM * s.nN; s.G = G; s.c = c;
        u.nt = d.K / BK; u.kind = 0;
        const int j = i * G + c - s.nwg; unsigned char* ws = a.ws;
        if (g2 == 2 || g2 == 13) {
            const int L = i * G + c;
            if (L >= 64) { const int L2 = L - 64; s.c = L2 % G; return s.next(L2 / G, u); }
            const int pm = L & 7, pn = L >> 3;
            u.A = (const char*)(ws + WS_MEMB) + (size_t)pm * BM * D * 2; u.B = (const char*)(ws + WS_WKV + (size_t)(g2 == 13) * 2 * SZ_DD) + (size_t)pn * BM * D * 2;
            u.row0 = pm * BM; u.col0 = 8192 + pn * BM; return true; }
        if ((g2 == 4 || g2 == 17) && j >= 0 && j < 256) {
            const int l = g2 == 17, which = j >> 7, jj = j & 127, b = jj >> 4, h = (jj >> 2) & 3, t4 = jj & 3; u.nt = 4;
            if (which == 0) { u.kind = 1; u.A = (const char*)(ws + WS_MEMK + (size_t)l * MEMR * D * 2) + ((size_t)(b * NMEM) * D + h * 256) * 2; u.B = (const char*)(ws + WS_WQN + (size_t)l * SZ_DD) + ((size_t)(t4 * 256) * D + h * 256) * 2;
                u.row0 = b * 1024 + h * 256; u.col0 = t4 * 256; }
            else { u.kind = 2; u.A = (const char*)(ws + WS_WO + (size_t)l * SZ_DD) + ((size_t)(t4 * 256) * D + h * 256) * 2; u.B = (const char*)(ws + WS_VT + (size_t)l * MEMR * D * 2) + ((size_t)(b * NMEM) * D + h * 256) * 2;
                u.row0 = t4 * 256; u.col0 = b * 1024 + h * 256; }
            return true; }
        return s.next(i, u);
    }
};
struct EpiAny { const Args& a; int gs0; LAS float* scr;
    __device__ __forceinline__ void operator()(const Acc& acc, const Unit& u, int wr, int wc, int fr_, int fq_) const {
        const int ov = opaque_v0(); const int fr = fr_ + ov, fq = fq_ + ov;
        const int z = opaque0(); const int gs = gs0 + z; unsigned char* ws = a.ws + z; float* SSQ = (float*)(ws + WS_SSQ);
        const int li = gs >= 15 ? 1 : 0, st = gs - 2 - 13 * li;
        if (u.kind == 1) { EpiPlain e{(bf16*)(ws + WS_WQK + (size_t)li * 8 * SZ_DD), (unsigned)D}; e(acc, u, wr, wc, fr, fq); }
        else if (u.kind == 2) { EpiPlain e{(bf16*)(ws + WS_VWT + (size_t)li * 8 * SZ_DD), (unsigned)(8 * D)}; e(acc, u, wr, wc, fr, fq); }
        else if ((st == 0 || st == 11) && u.col0 >= 8192) { const int l = st == 11; Unit v = u; v.col0 = u.col0 - 8192; const size_t lo = (size_t)l * MEMR * D;
            EpiKV e{a.out + OUT_MK + lo, a.out + OUT_MV + lo, (bf16*)(ws + WS_MEMK) + lo, (bf16*)(ws + WS_VT) + lo, (const float*)(ws + WS_MSSQ)}; e(acc, v, wr, wc, fr, fq); }
        else if (st == 0 || st == 11) { EpiGU e{(bf16*)(ws + WS_H), SSQ + (size_t)(li * 4 + (st == 11 ? 3 : 0)) * MPAD}; e(acc, u, wr, wc, fr, fq); }
        else if (st == 1 || st == 12 || st == 6 || st == 8) { const int so = li * 4 + (st == 1 ? 1 : st == 6 ? 2 : st == 8 ? 3 : 4);
            EpiRes e{gs == 3 ? INP(0) : (const float*)nullptr, (bf16*)(ws + WS_XB), SSQ + (size_t)so * MPAD, (st == 1 || st == 12) ? 0.5f : 1.f}; e(acc, u, wr, wc, fr, fq); }
        else if (st == 2) {
            if (li == 0) { EpiConvIn e{(bf16*)(ws + WS_M1), (bf16*)(ws + WS_M2), SSQ + (size_t)1 * MPAD, a.out + OUT_CP, a.out + OUT_CS}; e(acc, u, wr, wc, fr, fq); }
            else { EpiRecIn e{(bf16*)(ws + WS_M1), (_Float16*)(ws + WS_LOGF), (bf16*)(ws + WS_M2), (bf16*)(ws + WS_RG), SSQ + (size_t)5 * MPAD, INP(15)}; e(acc, u, wr, wc, fr, fq); } }
        else { EpiSoftmax e{(bf16*)(ws + WS_P), scr, SSQ + (size_t)(li * 4 + 2) * MPAD}; e(acc, u, wr, wc, fr, fq); }
    }
};
}
template <int NG, int MTN> __device__ __forceinline__ void skinny_acc(const bf16* Ap, const bf16* B0, const bf16* B1, int lda, int nks, f32x4 (&acc0)[8], f32x4 (&acc1)[8]) {
    constexpr int BT = (NG == 2 ? 2 : 4) * (MTN <= 4 ? 2 : 1);
#pragma unroll 1
    for (int k4 = 0; k4 < nks; k4 += BT) {
        bf16x8 b0[BT], b1[BT], av[BT][MTN];
#pragma unroll
        for (int s = 0; s < BT; ++s) { const int ks = (k4 + s < nks) ? k4 + s : nks - 1;
            b0[s] = *(const bf16x8*)(B0 + 32 * ks); if (NG == 2) b1[s] = *(const bf16x8*)(B1 + 32 * ks);
#pragma unroll
            for (int i = 0; i < MTN; ++i) av[s][i] = *(const bf16x8*)(Ap + (size_t)(16 * i) * lda + 32 * ks); }
#pragma unroll
        for (int s = 0; s < BT; ++s) if (k4 + s < nks) {
#pragma unroll
            for (int i = 0; i < MTN; ++i) { acc0[i] = mfma16(b0[s], av[s][i], acc0[i]); if (NG == 2) acc1[i] = mfma16(b1[s], av[s][i], acc1[i]); } }
    }
}
__device__ __forceinline__ void skinny_phase(LAS unsigned char* lds, const Args& a, int gs0, int G, int bx) {
    const int z = opaque0(); const int gs = gs0 + z; GemmDesc d; gemm_desc(a, gs, true, d);
    unsigned char* ws = a.ws + z; float* SSQ = (float*)(ws + WS_SSQ);
    const int li = gs >= 15 ? 1 : 0, st = gs - 2 - 13 * li;
    const int tid = otid(), lane = tid & 63, w = __builtin_amdgcn_readfirstlane(tid >> 6), r = lane & 15, q = lane >> 4;
    const bool conv = (st == 2 && li == 0);
    const int ngrp = conv ? 64 + 64 : d.N / 16;
    const int RS = ngrp <= 64 ? 4 : (ngrp <= 128 ? 2 : 1), mtn = 8 / RS, nunits = ngrp * RS;
    const int kw = d.K / 8, nks = kw / 32;
    LAS f32x4* R = (LAS f32x4*)lds;
    const int mt_e = tid >> 6;
    const int ssq_in = li * 4 + (st == 2 ? 1 : st == 7 ? 2 : 3);
#pragma unroll 1
    for (int uu = bx; uu < nunits; uu += G) {
        const int u = uu / RS, rq = uu % RS, rbase = rq * 16 * mtn;
        const int row_s = rbase + 16 * mt_e + r, grow = MP + row_s;
        const float rs = pg8::ssq_rstd(SSQ + (size_t)ssq_in * MPAD, grow);
        const bool pair = conv && u >= 64;
        int n0, n1;
        if (pair) { const int j = u - 64; n0 = D + (j >> 3) * 256 + (j & 7) * 16; n1 = n0 + 128; }
        else { n0 = 16 * u; n1 = n0; }
        f32x4 acc0[8], acc1[8];
#pragma unroll
        for (int i = 0; i < 8; ++i) { acc0[i] = (f32x4){0.f, 0.f, 0.f, 0.f}; acc1[i] = (f32x4){0.f, 0.f, 0.f, 0.f}; }
        const bf16* Ap = (const bf16*)d.A + (size_t)(MP + rbase + r) * d.lda + w * kw + 8 * q;
        const bf16* B0 = (const bf16*)d.B + (size_t)(n0 + r) * d.ldb + w * kw + 8 * q;
        const bf16* B1 = (const bf16*)d.B + (size_t)(n1 + r) * d.ldb + w * kw + 8 * q;
        if (RS == 4) skinny_acc<1, 2>(Ap, B0, B1, d.lda, nks, acc0, acc1);
        else if (RS == 2) { if (pair) skinny_acc<2, 4>(Ap, B0, B1, d.lda, nks, acc0, acc1); else skinny_acc<1, 4>(Ap, B0, B1, d.lda, nks, acc0, acc1); }
        else skinny_acc<1, 8>(Ap, B0, B1, d.lda, nks, acc0, acc1);
#pragma unroll
        for (int i = 0; i < 8; ++i) if (i < mtn) { R[(w * 8 + i) * 64 + lane] = acc0[i]; if (pair) R[4096 + (w * 8 + i) * 64 + lane] = acc1[i]; }
        __syncthreads();
        if (mt_e < mtn) {
        f32x4 v0 = R[mt_e * 64 + lane], v1 = (f32x4){0.f, 0.f, 0.f, 0.f};
#pragma unroll
        for (int k = 1; k < 8; ++k) v0 += R[(k * 8 + mt_e) * 64 + lane];
        if (pair) {
#pragma unroll
            for (int k = 0; k < 8; ++k) v1 += R[4096 + (k * 8 + mt_e) * 64 + lane]; }
        const unsigned c0 = n0 + 4 * q;
        if (st == 1 || st == 12 || st == 6 || st == 10) {
            const int so = li * 4 + (st == 1 ? 1 : st == 6 ? 2 : st == 10 ? 3 : 4); const float alpha = (st == 1 || st == 12) ? 0.5f : 1.f;
            bf16* XB = (bf16*)(ws + WS_XB); f32x4 xi;
            if (gs == 3) xi = *(const f32x4*)(INP(1) + (size_t)row_s * D + c0);
            else { const u32x2 xw = *(const u32x2*)(XB + (size_t)grow * D + c0); xi = (f32x4){bflo(xw.x), bfhi(xw.x), bflo(xw.y), bfhi(xw.y)}; }
            const f32x4 x0 = xi + v0 * alpha;
            *(u32x2*)(XB + (size_t)grow * D + c0) = pg8::pk4(x0);
            float ss = (x0[0] * x0[0] + x0[1] * x0[1]) + (x0[2] * x0[2] + x0[3] * x0[3]);
            ss += __shfl_xor(ss, 16); ss += __shfl_xor(ss, 32);
            if (q == 0) pg8::ssq_add(SSQ + (size_t)so * MPAD, grow, ss);
        } else if (conv) {
            if (!pair) { *(u32x2*)((bf16*)(ws + WS_M1) + (size_t)grow * D + c0) = pg8::pk4(v0 * rs); }
            else { const unsigned ch = (u - 64) * 16 + 4 * q; const f32x4 v = (v0 * rs) * (v1 * rs);
                *(u32x2*)((bf16*)(ws + WS_M2) + (size_t)grow * D + ch) = pg8::pk4(v); *(f32x4*)(a.out + OUT_CS + ((size_t)row_s * 2 + 1) * D + ch) = v; }
        } else if (st == 2) {
            const int part = n0 >> 10; const unsigned ch0 = (n0 & 1023) + 4 * q;
            f32x4 y0 = v0 * rs;
            if (part == 1) { const float* lbr = INP(15); f32x4 o0;
#pragma unroll
                for (int e = 0; e < 4; ++e) { const float lb0 = __builtin_amdgcn_rcpf(1.f + __expf(lbr[ch0 + e] - lbr[D + ch0 + e]));
                    o0[e] = lb0 + (1.f - lb0) * __builtin_amdgcn_rcpf(1.f + __expf(-y0[e])); }
                *(f16x4*)((_Float16*)(ws + WS_LOGF) + (size_t)grow * D + ch0) = __builtin_convertvector(o0, f16x4);
            } else { if (part != 2) {
#pragma unroll
                    for (int e = 0; e < 4; ++e) y0[e] = silu_f(y0[e]); }
                bf16* dst = (bf16*)(ws + (part == 0 ? WS_M1 : part == 2 ? WS_M2 : WS_RG));
                *(u32x2*)(dst + (size_t)grow * D + ch0) = pg8::pk4(y0); }
        } else {
            *(u32x2*)((bf16*)(ws + WS_Q) + (size_t)grow * D + c0) = pg8::pk4(v0 * (rs * QSCALE));
        }
        }
        __syncthreads();
    }
}

__global__ void __launch_bounds__(NTHR, 2) mega_fwd(Args a) {
    extern __shared__ __attribute__((aligned(16))) unsigned char lds_raw[];
    LAS unsigned char* lds = (LAS unsigned char*)lds_raw;
    const int tid = otid(), G = gridDim.x, bx = blockIdx.x;
    const int vcu = (G % 8 == 0) ? (bx % 8) * (G / 8) + bx / 8 : bx;
    volatile LAS unsigned* misc = (volatile LAS unsigned*)(lds + LDS_MISC);
    if (tid < 64) misc[tid] = 0u;
    __syncthreads();
    XcdBarrier bar = xcd_barrier_post((unsigned*)(a.ws + WS_CTL) + 1024, misc + 8);
    const int lo = a.ph_lo, hi = a.ph_hi;
#pragma unroll 1
    for (int gs = lo; gs < hi; ++gs) {
        const int z = opaque0(); unsigned char* ws = a.ws + z;
        const int li = gs >= 15 ? 1 : 0, st = gs - 2 - 13 * li;
        const bool layer_step = gs >= 2 && gs < 28;
        if (gs == 1 || (layer_step && ((li == 0 && (st == 4 || st == 5)) || st == 9))) continue;
        const int nrep = (gs == REP_GS) ? 1 + REP_N : 1;
#define PART(p) (rep == 0 || (REP_PARTS & (p)))
#pragma unroll 1
        for (int rep = 0; rep < nrep; ++rep) {
        if (gs == 0) { if (DM(0)) prologue(a, z, lds, vcu, G);
        } else if (gs == 28) {
            if (DM(13)) {
            const float* ssq = (const float*)(ws + WS_SSQ) + (size_t)8 * MPAD; const float* gf = INP(28); const bf16* XBf = (const bf16*)(ws + WS_XB);
            const int nth = G * NTHR, gt = vcu * NTHR + otid();
            if ((nth & 127) == 0) {
                const int c4 = (gt & 127) * 8; const f32x4 g0 = *(const f32x4*)(gf + c4), g1 = *(const f32x4*)(gf + c4 + 4);
#pragma unroll 1
                for (int it0 = gt; it0 < MT * 128; it0 += 4 * nth) { u32x4 xw[4]; float r[4];
#pragma unroll
                    for (int j = 0; j < 4; ++j) { const int it = it0 + j * nth; const int row = it < MT * 128 ? (it >> 7) : 0; xw[j] = *(const u32x4*)(XBf + (size_t)row * D + c4); r[j] = pg8::ssq_rstd(ssq, row); }
#pragma unroll
                    for (int j = 0; j < 4; ++j) { const int it = it0 + j * nth; if (it < MT * 128) { const int row = it >> 7;
                        const f32x4 v0 = (f32x4){bflo(xw[j].x), bfhi(xw[j].x), bflo(xw[j].y), bfhi(xw[j].y)} * r[j] * g0, v1 = (f32x4){bflo(xw[j].z), bfhi(xw[j].z), bflo(xw[j].w), bfhi(xw[j].w)} * r[j] * g1;
                        float* dst = row < MP ? a.out + OUT_YP + (size_t)row * D + c4 : a.out + OUT_YS + (size_t)(row - MP) * D + c4;
                        *(f32x4*)dst = v0; *((f32x4*)dst + 1) = v1; } } }
            } else {
            for (int it = gt; it < MT * 128; it += nth) { const int row = it >> 7, c4 = (it & 127) * 8;
                const float r = pg8::ssq_rstd(ssq, row); const u32x4 xw = *(const u32x4*)(XBf + (size_t)row * D + c4);
                const f32x4 v0 = (f32x4){bflo(xw.x), bfhi(xw.x), bflo(xw.y), bfhi(xw.y)} * r * *(const f32x4*)(gf + c4), v1 = (f32x4){bflo(xw.z), bfhi(xw.z), bflo(xw.w), bfhi(xw.w)} * r * *(const f32x4*)(gf + c4 + 4);
                float* dst = row < MP ? a.out + OUT_YP + (size_t)row * D + c4 : a.out + OUT_YS + (size_t)(row - MP) * D + c4;
                *(f32x4*)dst = v0; *((f32x4*)dst + 1) = v1; } } }
        } else if (layer_step && st == 3) {
            if (li == 0) { if (DM(6)) conv_phase(a, z, vcu, G); }
            else if (DM(7)) {
                   gla_g1_phase(lds, ws, bx, G);
#pragma unroll 1
                   for (int u = bx; u < NS * 8; u += G) sample_rec_unit(lds, a, z, u >> 3, u & 7); }
        } else if (layer_step && st == 4) { if (DM(8)) gla_g2(a, z, vcu, G);
        } else if (layer_step && st == 5) { if (DM(9)) {
            gla_g3_phase(lds, a, z, bx, G); }
        } else {
            if (DM(1) && PART(1) && st != 10) { GemmDesc d; gemm_desc(a, gs + z, false, d);
                pg8::SchedAny S{a, gs, G, bx}; pg8::EpiAny E{a, gs, (LAS float*)(lds + LDS_SCR)};
                pg8::gemm_phase(lds, d.K, d.lda, d.ldb, S, E); }
            if (layer_step && st != 8 && st != 0 && st != 11 && DM(14) && PART(2)) { __syncthreads(); skinny_phase(lds, a, gs, G, (bx + 128) % G); }
            if (st == 8 && DM(11) && PART(4)) {
                __syncthreads();
#pragma unroll 1
                for (int u = bx; u < NS * 2; u += G) sample_attn_unit(lds, INP(5) + (size_t)li * NS * NMEM * D, INP(6) + (size_t)li * NS * NMEM * D, (const bf16*)(ws + WS_Q), (bf16*)(ws + WS_O), u >> 1, u & 1);
            }
        }
        if (rep + 1 < nrep) xcd_barrier(bar);
        }
        if (gs + 1 < hi) { if (hi > 4096) cg::this_grid().sync();   xcd_barrier(bar); }
    }
}

extern "C" void kernel_launch(void* const* d_in, const int* in_sizes, int n_in, void* d_out, int out_size, void* d_ws, size_t ws_size, hipStream_t stream) {
    static int grid = 0;
    if (grid == 0) {
        if (n_in != 29 || ws_size < WS_END) { fprintf(stderr, "kernel_launch: unexpected n_in %d / ws %zu (need %zu)\n", n_in, ws_size, (size_t)WS_END); grid = -1; return; }
        int dev = 0, cus = 0, per_cu = 0;
        hipGetDevice(&dev); hipDeviceGetAttribute(&cus, hipDeviceAttributeMultiprocessorCount, dev);
        if (hipFuncSetAttribute((const void*)mega_fwd, hipFuncAttributeMaxDynamicSharedMemorySize, LDS_BYTES) != hipSuccess) { fprintf(stderr, "kernel_launch: hipFuncSetAttribute failed\n"); grid = -1; return; }
        hipOccupancyMaxActiveBlocksPerMultiprocessor(&per_cu, (const void*)mega_fwd, NTHR, LDS_BYTES);
        (void)hipGetLastError();
        if (per_cu < 1) fprintf(stderr, "kernel_launch: occupancy query says %d\n", per_cu);
        grid = cus;
    }
    if (grid < 0) return;
    hipMemsetAsync((char*)d_ws + WS_CTL, 0, CTL_BYTES, stream);
    Args a{};
    for (int i = 0; i < 29; ++i) a.in[i] = (const float*)d_in[i];
    a.out = (float*)d_out; a.ws = (unsigned char*)d_ws; a.ph_lo = 0; a.ph_hi = NSTEPS;
    void* args[] = {&a};
    hipError_t e = hipLaunchCooperativeKernel((const void*)mega_fwd, dim3(grid), dim3(NTHR), args, LDS_BYTES, stream);
    if (e != hipSuccess) fprintf(stderr, "cooperative launch failed: %s (grid %d)\n", hipGetErrorString(e), grid);
}
```
